# Optimizing an MI355X kernel written in HIP

```python
import math
import jax
import jax.numpy as jnp
from jax import lax
import numpy as np

D_MODEL = 1024
BATCH = 8
SEQ = 4096
DEPTH = 4

GRID_W = 64
CTX_LEN = 256
HEAD_DIM = 64
ROPE_BASE = 10000.0
LN_EPS = 1e-5

A_HEADS = D_MODEL // 256
A_KV_HEADS = A_HEADS // 2
A_GROUP = A_HEADS // A_KV_HEADS
A_WIDTH = A_HEADS * HEAD_DIM
A_KV_WIDTH = A_KV_HEADS * HEAD_DIM
WINDOW = 128

B_HEADS = 3 * D_MODEL // 512
B_QK_DIM = 32
B_V_DIM = 2 * B_QK_DIM
B_QK_WIDTH = B_HEADS * 2 * B_QK_DIM
B_WIDTH = B_HEADS * B_V_DIM
Q_BLOCK = 128

C_HEADS = 3 * D_MODEL // 512
C_WIDTH = C_HEADS * HEAD_DIM
C_GATE_WIDTH = 2 * 2 * C_HEADS
CHUNK = 64

D_MIX = A_WIDTH + B_WIDTH + C_WIDTH
D_IN = 2 * A_WIDTH + 2 * A_KV_WIDTH + 2 * B_QK_WIDTH + 2 * B_WIDTH + 5 * C_WIDTH + C_GATE_WIDTH

ALPHA = (2 * DEPTH) ** 0.25
BETA = (8 * DEPTH) ** -0.25

kernel_name = "hymba_style_diffusion_hybrid_block"


def layer_norm(x, g, b):
    xf = x.astype(jnp.float32)
    mu = xf.mean(-1, keepdims=True)
    var = jnp.mean(jnp.square(xf - mu), -1, keepdims=True)
    y = (xf - mu) * lax.rsqrt(var + LN_EPS)
    return (y * g.astype(jnp.float32) + b.astype(jnp.float32)).astype(x.dtype)


def rms_norm(x, g):
    xf = x.astype(jnp.float32)
    y = xf * lax.rsqrt(jnp.mean(jnp.square(xf), -1, keepdims=True) + LN_EPS)
    return (y * g.astype(jnp.float32)).astype(x.dtype)


def axial_rope_tables(n_tokens, dim):
    rows = n_tokens // GRID_W
    row = jnp.broadcast_to(jnp.arange(rows, dtype=jnp.float32)[:, None], (rows, GRID_W)).reshape(-1)
    col = jnp.broadcast_to(jnp.arange(GRID_W, dtype=jnp.float32)[None, :], (rows, GRID_W)).reshape(-1)
    n_freq = dim // 4
    inv = ROPE_BASE ** (-jnp.arange(n_freq, dtype=jnp.float32) / n_freq)
    ar = row[:, None] * inv
    ac = col[:, None] * inv
    ang = jnp.concatenate([ar, ar, ac, ac], -1)
    return jnp.cos(ang), jnp.sin(ang)


def apply_rope(x, tables):
    cos, sin = tables
    shp = (cos.shape[0],) + (1,) * (x.ndim - 3) + (cos.shape[1],)
    cos = cos.reshape(shp)
    sin = sin.reshape(shp)
    x1, x2, x3, x4 = jnp.split(x, 4, axis=-1)
    rot = jnp.concatenate([-x2, x1, -x4, x3], -1)
    return (x * cos + rot * sin).astype(x.dtype)


def sink_softmax(s, sink):
    m = jnp.maximum(s.max(-1, keepdims=True), sink)
    p = jnp.exp(s - m)
    return p / (p.sum(-1, keepdims=True) + jnp.exp(sink - m))


def window_attention(q, k, v, qc, kc, vc, sink, with_ctx):
    B, T = q.shape[:2]
    nb = T // WINDOW
    scale = HEAD_DIM ** -0.5
    sink = sink.astype(jnp.float32).reshape(A_KV_HEADS, A_GROUP)[:, :, None, None]
    qb = q.reshape(B, nb, WINDOW, A_KV_HEADS, A_GROUP, HEAD_DIM)
    pad = ((0, 0), (WINDOW, WINDOW), (0, 0), (0, 0))
    kp = jnp.pad(k, pad).reshape(B, nb + 2, WINDOW, A_KV_HEADS, HEAD_DIM)
    vp = jnp.pad(v, pad).reshape(B, nb + 2, WINDOW, A_KV_HEADS, HEAD_DIM)
    kb = jnp.concatenate([kp[:, :-2], kp[:, 1:-1], kp[:, 2:]], axis=2)
    vb = jnp.concatenate([vp[:, :-2], vp[:, 1:-1], vp[:, 2:]], axis=2)
    s_loc = jnp.einsum('bnqgrd,bnkgd->bngrqk', qb, kb, preferred_element_type=jnp.float32) * scale
    r = jnp.arange(WINDOW)[:, None]
    j = jnp.arange(3 * WINDOW)[None, :]
    rel = j - WINDOW - r
    kpos = jnp.arange(nb)[:, None, None] * WINDOW - WINDOW + j[None]
    mask = (jnp.abs(rel) <= WINDOW)[None] & (kpos >= 0) & (kpos < T)
    s_loc = jnp.where(mask[None, :, None, None], s_loc, -jnp.inf)
    s_ctx = jnp.einsum('bnqgrd,bkgd->bngrqk', qb, kc, preferred_element_type=jnp.float32) * scale
    p = sink_softmax(jnp.concatenate([s_loc, s_ctx], -1), sink)
    n_loc = 3 * WINDOW
    o = (jnp.einsum('bngrqk,bnkgd->bnqgrd', p[..., :n_loc].astype(v.dtype), vb)
         + jnp.einsum('bngrqk,bkgd->bnqgrd', p[..., n_loc:].astype(v.dtype), vc))
    y = o.reshape(B, T, A_WIDTH)
    yc = None
    if with_ctx:
        Cn = qc.shape[1]
        qcb = qc.reshape(B, Cn, A_KV_HEADS, A_GROUP, HEAD_DIM)
        sc = jnp.einsum('bqgrd,bkgd->bgrqk', qcb, kc, preferred_element_type=jnp.float32) * scale
        pc = sink_softmax(sc, sink)
        yc = jnp.einsum('bgrqk,bkgd->bqgrd', pc.astype(vc.dtype), vc).reshape(B, Cn, A_WIDTH)
    return y, yc


def diff_attention(q, k, v, qc, kc, vc, lam, lam_init, norm_g, with_ctx):
    B, T = q.shape[:2]
    scale = B_QK_DIM ** -0.5

    def attend(qblk, keys, vals):
        s = jnp.einsum('bqhmd,bkhmd->bhmqk', qblk, keys, preferred_element_type=jnp.float32) * scale
        p = jax.nn.softmax(s, axis=-1)
        pd = p[:, :, 0] - lam * p[:, :, 1]
        return jnp.einsum('bhqk,bkhv->bqhv', pd.astype(vals.dtype), vals)

    k_all = jnp.concatenate([k, kc], axis=1)
    v_all = jnp.concatenate([v, vc], axis=1)
    nb = T // Q_BLOCK
    q_blocks = jnp.moveaxis(q.reshape(B, nb, Q_BLOCK, B_HEADS, 2, B_QK_DIM), 1, 0)
    o = lax.map(lambda qb: attend(qb, k_all, v_all), q_blocks)
    o = jnp.moveaxis(o, 0, 1).reshape(B, T, B_HEADS, B_V_DIM)
    y = (rms_norm(o, norm_g) * (1.0 - lam_init)).reshape(B, T, B_WIDTH)
    yc = None
    if with_ctx:
        oc = attend(qc, kc, vc)
        yc = (rms_norm(oc, norm_g) * (1.0 - lam_init)).reshape(B, qc.shape[1], B_WIDTH)
    return y, yc


def mlstm_scan(q, k, v, i_pre, logf, state):
    B, H, T, d = q.shape
    nc = T // CHUNK

    def to_chunks(a):
        return jnp.moveaxis(a.reshape(a.shape[:2] + (nc, CHUNK) + a.shape[3:]), 2, 0)

    xs = (to_chunks(q), to_chunks(k), to_chunks(v), to_chunks(i_pre), to_chunks(logf))
    lower = jnp.tril(jnp.ones((CHUNK, CHUNK), dtype=bool))

    def step(carry, inp):
        Cm, n, m = carry
        qc, kc, vc, ic, fc = inp
        b = jnp.cumsum(fc, axis=-1)
        log_d = jnp.where(lower, b[..., :, None] - b[..., None, :] + ic[..., None, :], -jnp.inf)
        m_inter = b + m[..., None]
        m_t = jnp.maximum(m_inter, log_d.max(-1))
        dmat = jnp.exp(log_d - m_t[..., None])
        s = jnp.einsum('bhtd,bhsd->bhts', qc, kc) * dmat
        w_inter = jnp.exp(m_inter - m_t)
        num = w_inter[..., None] * jnp.einsum('bhvd,bhtd->bhtv', Cm, qc) + jnp.einsum('bhts,bhsv->bhtv', s, vc)
        den = w_inter * jnp.einsum('bhd,bhtd->bht', n, qc) + s.sum(-1)
        h = num / jnp.maximum(jnp.abs(den), jnp.exp(-m_t))[..., None]
        b_last = b[..., -1]
        log_w = b_last[..., None] - b + ic
        m_new = jnp.maximum(b_last + m, log_w.max(-1))
        w = jnp.exp(log_w - m_new[..., None])
        decay = jnp.exp(b_last + m - m_new)
        C_new = decay[..., None, None] * Cm + jnp.einsum('bhs,bhsv,bhsd->bhvd', w, vc, kc)
        n_new = decay[..., None] * n + jnp.einsum('bhs,bhsd->bhd', w, kc)
        return (C_new, n_new, m_new), h

    state, hs = lax.scan(step, state, xs)
    return jnp.moveaxis(hs, 0, 2).reshape(B, H, T, d), state


def mlstm_branch(q, k, v, o, gates, qc, kc, vc, oc, gates_c, i_bias, f_bias, norm_g):
    def prep(q, k, v, gates):
        bht = lambda a: jnp.transpose(a, (0, 2, 1, 3)).astype(jnp.float32)
        g = jnp.transpose(gates.astype(jnp.float32), (2, 3, 0, 4, 1))
        return bht(q), bht(k) * HEAD_DIM ** -0.5, bht(v), g

    ql, kl, vl, gl = prep(q, k, v, gates)
    qx, kx, vx, gx = prep(qc, kc, vc, gates_c)
    B, H, _, d = ql.shape
    zero = (jnp.zeros((B, H, d, d), jnp.float32), jnp.zeros((B, H, d), jnp.float32), jnp.zeros((B, H), jnp.float32))
    flip = lambda a: jnp.flip(a, axis=2)
    h_lat_dirs = []
    h_ctx_dirs = []
    for direction in range(2):
        ib = i_bias[direction].astype(jnp.float32)[:, None]
        fb = f_bias[direction].astype(jnp.float32)[:, None]
        lat = (ql, kl, vl, gl[direction, 0] + ib, jax.nn.log_sigmoid(gl[direction, 1] + fb))
        cx = (qx, kx, vx, gx[direction, 0] + ib, jax.nn.log_sigmoid(gx[direction, 1] + fb))
        if direction == 1:
            lat = tuple(flip(a) for a in lat)
            cx = tuple(flip(a) for a in cx)
        hx, st = mlstm_scan(*cx, zero)
        hl, _ = mlstm_scan(*lat, st)
        if direction == 1:
            hx, hl = flip(hx), flip(hl)
        h_lat_dirs.append(hl)
        h_ctx_dirs.append(hx)
    g = norm_g.reshape(C_HEADS, HEAD_DIM)

    def finish(h, o_gate):
        h = rms_norm(jnp.transpose(h, (0, 2, 1, 3)), g)
        return (h.reshape(h.shape[0], h.shape[1], C_WIDTH) * jax.nn.sigmoid(o_gate.astype(jnp.float32))).astype(q.dtype)

    return (finish(h_lat_dirs[0] + h_lat_dirs[1], o), finish(h_ctx_dirs[0] + h_ctx_dirs[1], oc))


def split_proj(p):
    sizes = (A_WIDTH, A_KV_WIDTH, A_KV_WIDTH, A_WIDTH,
             B_QK_WIDTH, B_QK_WIDTH, B_WIDTH, B_WIDTH,
             C_WIDTH, C_WIDTH, C_WIDTH, C_WIDTH, C_WIDTH, C_GATE_WIDTH)
    return jnp.split(p, np.cumsum(sizes)[:-1].tolist(), axis=-1)


def heads(t, *shape):
    return t.reshape(t.shape[:2] + shape)


def hybrid_layer(x, ctx, c, c_ctx, w_mod, b_mod, w_in, sink, lam_vec, lam_init, diff_g,
                 i_bias, f_bias, mlstm_g, w_out, ln_g, ln_b, rope_a, rope_b, with_ctx):
    mod = jax.nn.silu(c) @ w_mod + b_mod
    mod_c = jax.nn.silu(c_ctx) @ w_mod + b_mod
    shift, scale, gate = jnp.split(mod, 3, axis=-1)
    shift_c, scale_c, gate_c = jnp.split(mod_c, 3, axis=-1)
    h = x * (1.0 + scale[:, None]) + shift[:, None]
    hc = ctx * (1.0 + scale_c) + shift_c
    qa, ka, va, za, qb, kb, vb, zb, qm, km, vm, om, zm, gm = split_proj(h @ w_in)
    qa_c, ka_c, va_c, za_c, qb_c, kb_c, vb_c, zb_c, qm_c, km_c, vm_c, om_c, zm_c, gm_c = split_proj(hc @ w_in)

    ya, ya_c = window_attention(
        apply_rope(heads(qa, A_HEADS, HEAD_DIM), rope_a), apply_rope(heads(ka, A_KV_HEADS, HEAD_DIM), rope_a),
        heads(va, A_KV_HEADS, HEAD_DIM),
        heads(qa_c, A_HEADS, HEAD_DIM), heads(ka_c, A_KV_HEADS, HEAD_DIM), heads(va_c, A_KV_HEADS, HEAD_DIM),
        sink, with_ctx)

    lv = lam_vec.astype(jnp.float32)
    lam = jnp.exp(jnp.sum(lv[0] * lv[1])) - jnp.exp(jnp.sum(lv[2] * lv[3])) + lam_init
    yb, yb_c = diff_attention(
        apply_rope(heads(qb, B_HEADS, 2, B_QK_DIM), rope_b), apply_rope(heads(kb, B_HEADS, 2, B_QK_DIM), rope_b),
        heads(vb, B_HEADS, B_V_DIM),
        heads(qb_c, B_HEADS, 2, B_QK_DIM), heads(kb_c, B_HEADS, 2, B_QK_DIM), heads(vb_c, B_HEADS, B_V_DIM),
        lam, lam_init, diff_g, with_ctx)

    ym, ym_c = mlstm_branch(
        heads(qm, C_HEADS, HEAD_DIM), heads(km, C_HEADS, HEAD_DIM), heads(vm, C_HEADS, HEAD_DIM), om,
        heads(gm, 2, 2, C_HEADS),
        heads(qm_c, C_HEADS, HEAD_DIM), heads(km_c, C_HEADS, HEAD_DIM), heads(vm_c, C_HEADS, HEAD_DIM), om_c,
        heads(gm_c, 2, 2, C_HEADS),
        i_bias, f_bias, mlstm_g)

    y = jnp.concatenate([ya * jax.nn.silu(za), yb * jax.nn.silu(zb), ym * jax.nn.silu(zm)], -1) @ w_out
    x_new = layer_norm(ALPHA * x + gate[:, None] * y, ln_g, ln_b)
    ctx_new = None
    if with_ctx:
        yc = jnp.concatenate([ya_c * jax.nn.silu(za_c), yb_c * jax.nn.silu(zb_c), ym_c * jax.nn.silu(zm_c)], -1) @ w_out
        ctx_new = layer_norm(ALPHA * ctx + gate_c * yc, ln_g, ln_b)
    return x_new, ctx_new


def setup_inputs(seed: int = 0) -> dict:
    key = jax.random.key(seed)
    ks = jax.random.split(key, 16)

    def nrm(k, shape, s):
        return jax.random.normal(k, shape, jnp.float32) * s

    return {
        "x": nrm(ks[0], (BATCH, SEQ, D_MODEL), 1.0),
        "c": nrm(ks[1], (BATCH, D_MODEL), 1.0),
        "ctx": nrm(ks[2], (BATCH, CTX_LEN, D_MODEL), 1.0),
        "c_ctx": nrm(ks[3], (D_MODEL,), 1.0),
        "w_mod": nrm(ks[4], (DEPTH, D_MODEL, 3 * D_MODEL), 0.5 * D_MODEL ** -0.5),
        "b_mod": nrm(ks[5], (DEPTH, 3 * D_MODEL), 0.02),
        "w_in": nrm(ks[6], (DEPTH, D_MODEL, D_IN), D_MODEL ** -0.5),
        "attn_sink": nrm(ks[7], (DEPTH, A_HEADS), 0.5),
        "diff_lambda": nrm(ks[8], (DEPTH, 4, B_QK_DIM), 0.1),
        "diff_norm_g": 1.0 + nrm(ks[9], (DEPTH, B_V_DIM), 0.02),
        "mlstm_i_bias": nrm(ks[10], (DEPTH, 2, C_HEADS), 0.1),
        "mlstm_f_bias": jnp.linspace(3.0, 6.0, C_HEADS, dtype=jnp.float32) + nrm(ks[11], (DEPTH, 2, C_HEADS), 0.1),
        "mlstm_norm_g": 1.0 + nrm(ks[12], (DEPTH, C_WIDTH), 0.02),
        "w_out": nrm(ks[13], (DEPTH, D_MIX, D_MODEL), BETA * D_MIX ** -0.5),
        "ln_g": 1.0 + nrm(ks[14], (DEPTH, D_MODEL), 0.02),
        "ln_b": nrm(ks[15], (DEPTH, D_MODEL), 0.02),
    }


def reference(x, c, ctx, c_ctx, w_mod, b_mod, w_in, attn_sink, diff_lambda, diff_norm_g,
              mlstm_i_bias, mlstm_f_bias, mlstm_norm_g, w_out, ln_g, ln_b):
    T = x.shape[1]
    rope_a = axial_rope_tables(T, HEAD_DIM)
    rope_b = axial_rope_tables(T, B_QK_DIM)
    for l in range(DEPTH):
        lam_init = 0.8 - 0.6 * math.exp(-0.3 * l)
        x, ctx = hybrid_layer(x, ctx, c, c_ctx, w_mod[l], b_mod[l], w_in[l], attn_sink[l], diff_lambda[l],
                              lam_init, diff_norm_g[l], mlstm_i_bias[l], mlstm_f_bias[l], mlstm_norm_g[l],
                              w_out[l], ln_g[l], ln_b[l], rope_a, rope_b, with_ctx=(l < DEPTH - 1))
    return x
```

```cpp
#include <hip/hip_runtime.h>
#include <hip/hip_cooperative_groups.h>
#include <cstdio>
namespace cg = cooperative_groups;

#ifndef LAYER_LOOP_PRAGMA
#define LAYER_LOOP_PRAGMA _Pragma("nounroll")
#endif
#ifndef ONE_LAUNCH
#define ONE_LAUNCH 1
#endif

typedef unsigned short u16;
typedef __attribute__((ext_vector_type(8))) short bf16x8;
typedef __attribute__((ext_vector_type(4))) short s16x4;
typedef __attribute__((ext_vector_type(16))) float f32x16;
typedef __attribute__((ext_vector_type(2))) float f32x2;
typedef __attribute__((ext_vector_type(2))) __bf16 bf2_t;
#define DI __device__ __forceinline__
#define MFMA(a, b, c) __builtin_amdgcn_mfma_f32_32x32x16_bf16((a), (b), (c), 0, 0, 0)

constexpr int DM = 1024, NBATCH = 8, SEQ = 4096, CTXL = 256, DEPTH = 4;
constexpr int NLAT = NBATCH * SEQ;
constexpr int NCTX = NBATCH * CTXL;
constexpr int NTOK = NLAT + NCTX;
constexpr int DIN = 4248, NPAD = 4352;
constexpr int PC = 3392;
constexpr int LDK = 1024;
constexpr int KVS = 4416;
constexpr int KVL = SEQ + CTXL;
constexpr int P_QA = 0, P_KA = 256, P_ZA = 384, P_QB = 640, P_KB = 1024, P_ZB = 1408, P_QM = 1792, P_KM = 2176, P_OM = 2560, P_ZM = 2944;
constexpr float LN_EPS = 1e-5f;
constexpr float ALPHA = 1.6817928305074290f;
constexpr float LOG2E = 1.4426950408889634f;

constexpr size_t SZ_WI = 4ull * NPAD * LDK * 2, SZ_WO = 4ull * 1024 * LDK * 2, SZ_MOD = 4ull * 9 * 3072 * 4;
constexpr size_t OFF_WI = 0;
constexpr size_t OFF_WO = OFF_WI + SZ_WI;
constexpr size_t OFF_MOD = OFF_WO + SZ_WO;
constexpr size_t OFF_TABA = OFF_MOD + SZ_MOD;
constexpr size_t OFF_TABB = OFF_TABA + 8192;
constexpr size_t OFF_LAM = OFF_TABB + 4096;
constexpr size_t OFF_CTR = OFF_LAM + 256;
constexpr size_t OFF_HY = OFF_CTR + 256;
constexpr size_t OFF_P = OFF_HY + (size_t)NTOK * LDK * 2;
constexpr size_t OFF_G = OFF_P + (size_t)NTOK * PC * 2;
constexpr size_t OFF_VAT = OFF_G + (size_t)NTOK * 24 * 4;
constexpr size_t OFF_VBT = OFF_VAT + (size_t)NBATCH * 2 * 64 * KVS * 2;
constexpr size_t OFF_KMT = OFF_VBT + (size_t)NBATCH * 6 * 64 * KVS * 2;
constexpr size_t OFF_VMT = OFF_KMT + (size_t)NBATCH * 6 * 64 * KVS * 2;
constexpr size_t OFF_HD = OFF_VMT + (size_t)NBATCH * 6 * 64 * KVS * 2;
constexpr size_t OFF_XC = OFF_HD + 2ull * NTOK * 384 * 2;
constexpr size_t OFF_BAR = OFF_XC + (size_t)NCTX * 1024 * 4;
constexpr size_t BAR_BYTES = 16384;
constexpr int BAR_FINRDY_W = 3500;
constexpr int BAR_MIXCTR_W = 3700;
constexpr size_t WS_END = OFF_BAR + BAR_BYTES;

struct Params {
    const float *x, *c, *ctx, *c_ctx, *w_mod, *b_mod, *w_in, *sink, *dlam, *dng, *ib, *fb, *mng, *w_out, *ln_g, *ln_b;
    float* out;
    char* ws;
};

constexpr int SMEM_BYTES = 75776;
constexpr int DYN_LDS = 2 * SMEM_BYTES + 64;

DI unsigned pk2(float a, float b) { f32x2 v = {a, b}; bf2_t r = __builtin_convertvector(v, bf2_t); return __builtin_bit_cast(unsigned, r); }
DI u16 f2bf(float a) { return (u16)(pk2(a, 0.f) & 0xffffu); }
DI float bf2f(u16 v) { return __uint_as_float(((unsigned)v) << 16); }
DI float bflo(unsigned v) { return __uint_as_float(v << 16); }
DI float bfhi(unsigned v) { return __uint_as_float(v & 0xffff0000u); }
DI int crow(int e, int h) { return (e & 3) + 8 * (e >> 2) + 4 * h; }
DI float silu_f(float v) { return v / (1.f + __expf(-v)); }
DI float sigmoid_f(float v) { return 1.f / (1.f + __expf(-v)); }
DI bf16x8 pack8(const f32x16& x, int s) {
    uint4 u;
    u.x = pk2(x[8 * s + 0], x[8 * s + 1]); u.y = pk2(x[8 * s + 2], x[8 * s + 3]);
    u.z = pk2(x[8 * s + 4], x[8 * s + 5]); u.w = pk2(x[8 * s + 6], x[8 * s + 7]);
    return __builtin_bit_cast(bf16x8, u);
}
DI bf16x8 ld8(const u16* p) { return __builtin_bit_cast(bf16x8, *(const uint4*)p); }
DI bf16x8 ld4x2(const u16* p0, const u16* p1) { uint2 a = *(const uint2*)p0, b = *(const uint2*)p1; uint4 u = {a.x, a.y, b.x, b.y}; return __builtin_bit_cast(bf16x8, u); }
DI int lane_id() { int l; asm volatile("v_mbcnt_lo_u32_b32 %0, -1, 0\n\tv_mbcnt_hi_u32_b32 %0, -1, %0" : "=v"(l)); return l; }
struct VBC;
DI int opaque_tid(const VBC& vc);
typedef __attribute__((address_space(3))) unsigned lds_u32;
struct VBC { lds_u32* cnt; unsigned gen; int* mail; int wid; };
DI int opaque_tid(const VBC& vc) { int t = ((vc.wid & 3) << 6) | lane_id(); asm volatile("" : "+v"(t)); return t; }
#define VBID ((int)(blockIdx.x * 2 + (vc.wid >> 2)))
#define VGRID ((int)(gridDim.x * 2))
DI void vb_sync(VBC& vc) {
    vc.gen += 4u;
    __builtin_amdgcn_fence(__ATOMIC_RELEASE, "workgroup");
    asm volatile("s_waitcnt lgkmcnt(0)" ::: "memory");
    if (lane_id() == 0) __hip_atomic_fetch_add(vc.cnt, 1u, __ATOMIC_RELAXED, __HIP_MEMORY_SCOPE_WORKGROUP);
    while (__hip_atomic_load(vc.cnt, __ATOMIC_RELAXED, __HIP_MEMORY_SCOPE_WORKGROUP) < vc.gen) __builtin_amdgcn_s_sleep(1);
    __builtin_amdgcn_fence(__ATOMIC_ACQUIRE, "workgroup");
}
#define VSYNC() vb_sync(vc)
DI float wave_sum(float v) { for (int o = 32; o > 0; o >>= 1) v += __shfl_xor(v, o); return v; }
DI float wave_max(float v) { for (int o = 32; o > 0; o >>= 1) v = fmaxf(v, __shfl_xor(v, o)); return v; }

DI int wi_src(int n, float& sc) {
    sc = 1.f;
    if (n >= DIN) return -1;
    if (n < 384) {
        int p = n & 63, base = n & ~63, d;
        if (p < 32) d = (p >> 1) + 16 * (p & 1); else { int q = p - 32; d = 32 + (q >> 1) + 16 * (q & 1); }
        if (n < 256) sc = 0.125f * LOG2E;
        return base + d;
    }
    if (n >= 768 && n < 1536) {
        int p = n & 31, base = n & ~31, d;
        if (p < 16) d = (p >> 1) + 8 * (p & 1); else { int q = p - 16; d = 16 + (q >> 1) + 8 * (q & 1); }
        if (n < 1152) sc = 0.17677669529663687f * LOG2E;
        return base + d;
    }
    if (n >= 2688 && n < 3072) sc = 0.125f;
    return n;
}

DI void sincos_d(double a, float& c, float& s) {
    const double TWO_PI = 6.283185307179586476925;
    double k = rint(a / TWO_PI);
    double r = a - k * TWO_PI;
    double r2 = r * r, ts = r, tc = 1.0, ss = r, cc = 1.0;
    for (int i = 1; i <= 13; ++i) {
        tc *= -r2 / (double)((2 * i - 1) * (2 * i)); cc += tc;
        ts *= -r2 / (double)((2 * i) * (2 * i + 1)); ss += ts;
    }
    c = (float)cc; s = (float)ss;
}

DI void phase_pro1(const Params& p, char* smem, VBC& vc) {
    const int tid = opaque_tid(vc);
    u16* WI = (u16*)(p.ws + OFF_WI);
    u16* WO = (u16*)(p.ws + OFF_WO);
    float* MOD = (float*)(p.ws + OFF_MOD);
    const long total_wi = 4L * 128 * NPAD, total_wo = 4L * 128 * 1024;
    for (long idx = (long)VBID * 256 + tid; idx < total_wi + total_wo; idx += (long)VGRID * 256) {
        if (idx < total_wi) {
            int n = (int)(idx % NPAD); long t = idx / NPAD; int kg = (int)(t % 128), l = (int)(t / 128);
            float sc; int src = wi_src(n, sc);
            uint4 o = {0u, 0u, 0u, 0u};
            if (src >= 0) {
                const float* w = p.w_in + ((size_t)l * 1024 + kg * 8) * DIN + src;
                float v[8];
#pragma unroll
                for (int i = 0; i < 8; ++i) v[i] = w[(size_t)i * DIN] * sc;
                o.x = pk2(v[0], v[1]); o.y = pk2(v[2], v[3]); o.z = pk2(v[4], v[5]); o.w = pk2(v[6], v[7]);
            }
            *(uint4*)(WI + ((size_t)l * NPAD + n) * LDK + kg * 8) = o;
        } else {
            long j = idx - total_wi;
            int n = (int)(j % 1024); long t = j / 1024; int kg = (int)(t % 128), l = (int)(t / 128);
            const float* w = p.w_out + ((size_t)l * 1024 + kg * 8) * 1024 + n;
            float v[8];
#pragma unroll
            for (int i = 0; i < 8; ++i) v[i] = w[(size_t)i * 1024];
            uint4 o; o.x = pk2(v[0], v[1]); o.y = pk2(v[2], v[3]); o.z = pk2(v[4], v[5]); o.w = pk2(v[6], v[7]);
            *(uint4*)(WO + ((size_t)l * 1024 + n) * LDK + kg * 8) = o;
        }
    }
    float* ssc = (float*)smem;
    float* red = ssc + 9 * 1024;
    bool have = false;
    for (int item = VBID; item < 384; item += VGRID) {
        if (!have) {
            for (int i = tid; i < 9216; i += 256) { int r = i >> 10, k = i & 1023; float v = r < 8 ? p.c[r * 1024 + k] : p.c_ctx[k]; ssc[i] = silu_f(v); }
            VSYNC(); have = true;
        }
        const int l = item / 96, n0 = (item % 96) * 32, nl = tid & 31, ks = tid >> 5;
        const float* w = p.w_mod + ((size_t)l * 1024 + ks * 128) * 3072 + n0 + nl;
        float acc[9];
#pragma unroll
        for (int r = 0; r < 9; ++r) acc[r] = 0.f;
#pragma unroll 8
        for (int k = 0; k < 128; ++k) {
            float wv = w[(size_t)k * 3072];
#pragma unroll
            for (int r = 0; r < 9; ++r) acc[r] += ssc[r * 1024 + ks * 128 + k] * wv;
        }
#pragma unroll
        for (int r = 0; r < 9; ++r) red[(ks * 9 + r) * 32 + nl] = acc[r];
        VSYNC();
        for (int o = tid; o < 288; o += 256) {
            int r = o >> 5, nn = o & 31; float s = p.b_mod[l * 3072 + n0 + nn];
            for (int k2 = 0; k2 < 8; ++k2) s += red[(k2 * 9 + r) * 32 + nn];
            MOD[((size_t)l * 9 + r) * 3072 + n0 + nn] = s;
        }
        VSYNC();
    }
    if (VBID == VGRID - 1) {
        float2* TA = (float2*)(p.ws + OFF_TABA); float2* TB = (float2*)(p.ws + OFF_TABB);
        for (int i = tid; i < 1536; i += 256) {
            int pos, j, nf; if (i < 1024) { pos = i >> 4; j = i & 15; nf = 16; } else { int q = i - 1024; pos = q >> 3; j = q & 7; nf = 8; }
            float inv = (float)exp(-(double)j / (double)nf * 9.210340371976184);
            float ang = (float)pos * inv;
            float c, s; sincos_d((double)ang, c, s);
            if (i < 1024) TA[i] = make_float2(c, s); else TB[i - 1024] = make_float2(c, s);
        }
        if (tid < 4) {
            const float* lv = p.dlam + tid * 128; float s0 = 0.f, s1 = 0.f;
            for (int i = 0; i < 32; ++i) { s0 += lv[i] * lv[32 + i]; s1 += lv[64 + i] * lv[96 + i]; }
            float li = (float)(0.8 - 0.6 * exp(-0.3 * (double)tid));
            float* L = (float*)(p.ws + OFF_LAM); L[tid * 2] = expf(s0) - expf(s1) + li; L[tid * 2 + 1] = li;
        }
        if (tid < 64) ((int*)(p.ws + OFF_CTR))[tid] = 0;
    }
}

DI void phase_pro2(const Params& p, const VBC& vc) {
    u16* H = (u16*)(p.ws + OFF_HY);
    const float* MOD = (const float*)(p.ws + OFF_MOD);
    const int tid = opaque_tid(vc);
    for (long idx = (long)VBID * 256 + tid; idx < (long)NTOK * 128; idx += (long)VGRID * 256) {
        int row = (int)(idx >> 7), kg = (int)(idx & 127);
        const float* src = row < NLAT ? p.x + (size_t)row * 1024 : p.ctx + (size_t)(row - NLAT) * 1024;
        int r = row < NLAT ? (row >> 12) : 8;
        const float* md = MOD + (size_t)r * 3072 + kg * 8;
        float4 a0 = *(const float4*)(src + kg * 8), a1 = *(const float4*)(src + kg * 8 + 4);
        float4 sh0 = *(const float4*)(md), sh1 = *(const float4*)(md + 4), sc0 = *(const float4*)(md + 1024), sc1 = *(const float4*)(md + 1028);
        uint4 o;
        o.x = pk2(a0.x * (1.f + sc0.x) + sh0.x, a0.y * (1.f + sc0.y) + sh0.y);
        o.y = pk2(a0.z * (1.f + sc0.z) + sh0.z, a0.w * (1.f + sc0.w) + sh0.w);
        o.z = pk2(a1.x * (1.f + sc1.x) + sh1.x, a1.y * (1.f + sc1.y) + sh1.y);
        o.w = pk2(a1.z * (1.f + sc1.z) + sh1.z, a1.w * (1.f + sc1.w) + sh1.w);
        *(uint4*)(H + (size_t)row * LDK + kg * 8) = o;
    }
}

namespace pg8 {
#define PG8_LAS __attribute__((address_space(3)))
typedef unsigned short bf16_t;
typedef float f32x4 __attribute__((ext_vector_type(4)));
constexpr int BM = 256, BK = 64, HALF = 128, HTB = HALF * BK * 2  , STAGE_BYTES = 8 * HTB, NXCD = 8, WGM = 8;
DI int lds_byte(int r, int c) { const int st = (r >> 4) * 2 + (c >> 5), rr = r & 15, cc = c & 31, ob = rr * 64 + cc * 2; return st * 1024 + (ob ^ (((ob >> 9) & 1) << 5)); }
DI void stage_rc(int b, int& R, int& C) { const int st = b / 1024, sb = b % 1024, swz = sb ^ (((sb >> 9) & 1) << 5); R = (st >> 1) * 16 + swz / 64; C = (st & 1) * 32 + (swz % 64) / 2; }
DI int perm32(int rho) { const int n = rho >> 4, i = rho & 15; return 8 * (i >> 2) + 4 * n + (i & 3); }
struct Unit { int pm, pn; };
struct Gemm { const bf16_t* A; const bf16_t* Bt; int M, N, K; };
struct StaticOrder {
    int nM, nN, nwg, G, c;
    DI void init(int M, int N, int G_, int c_) { nM = M / BM; nN = N / BM; nwg = nM * nN; G = G_; c = c_; }
    DI bool next(int i, Unit& u) const {
        const long L = (long)i * G + c; if (L >= nwg) return false;
        int wgid = (int)L; { const int q = nwg / NXCD, r = nwg % NXCD, xcd = wgid % NXCD, off = wgid / NXCD; wgid = (xcd < r ? xcd * (q + 1) : r * (q + 1) + (xcd - r) * q) + off; }
        const int nig = WGM * nN, gid = wgid / nig, fm = gid * WGM, gsz = (nM - fm) < WGM ? (nM - fm) : WGM;
        u.pm = fm + ((wgid % nig) % gsz); u.pn = (wgid % nig) / gsz; return true;
    }
};
template <class Epi>
DI void gemm_phase(PG8_LAS unsigned char* lds, const Gemm g, const StaticOrder& S, const Epi& E, const int wid0) {
    int tid = (wid0 << 6) | lane_id(); asm volatile("" : "+v"(tid));
    const int wid = __builtin_amdgcn_readfirstlane(tid >> 6), lane = tid & 63, wr = wid >> 2, wc = wid & 3, fr = lane & 15, fq = lane >> 4;
    const int K = g.K, nt = K / BK;
    unsigned voffA[2], voffB[2];
#pragma unroll
    for (int i = 0; i < 2; ++i) { int R, C; stage_rc(tid * 16 + i * 8192, R, C); const int Rb = Epi::PERM ? ((R & ~31) + perm32(R & 31)) : R;
        voffA[i] = (unsigned)(R * K + C) * 2u; voffB[i] = (unsigned)(Rb * K + C) * 2u; }
    const size_t kstep = (size_t)(BK * 2);
    const size_t hstep = (size_t)HALF * K * 2;
    const size_t tstep = 2 * hstep;
    const unsigned ldsw = (unsigned)wid * 1024u;
    const int aoff = lds_byte(wr * 64 + fr, fq * 8), boff = lds_byte(wc * 32 + fr, fq * 8);
#define PG8_SA(b, h) (((b) * 2 + (h)) * HTB)
#define PG8_SB(b, h) ((4 + (b) * 2 + (h)) * HTB)
#define PG8_STAGE(bufoff, gbase, voff) do { _Pragma("unroll") for (int _i = 0; _i < 2; ++_i) \
        __builtin_amdgcn_global_load_lds((const unsigned*)((const char*)(gbase) + (voff)[_i]), (PG8_LAS unsigned*)(lds + (bufoff) + ldsw + _i * 8192), 16, 0, 0); } while (0)
#define PG8_LDA(dst, b, h) do { _Pragma("unroll") for (int m = 0; m < 4; ++m) _Pragma("unroll") for (int k = 0; k < 2; ++k) dst[m][k] = *(const PG8_LAS bf16x8*)(lds + PG8_SA(b, h) + aoff + m * 2048 + k * 1024); } while (0)
#define PG8_LDB(dst, b, h) do { _Pragma("unroll") for (int n = 0; n < 2; ++n) _Pragma("unroll") for (int k = 0; k < 2; ++k) dst[n][k] = *(const PG8_LAS bf16x8*)(lds + PG8_SB(b, h) + boff + n * 2048 + k * 1024); } while (0)
#define PG8_MMA(ai, bj, At, Bt) do { __builtin_amdgcn_s_setprio(1); _Pragma("unroll") for (int m = 0; m < 4; ++m) _Pragma("unroll") for (int n = 0; n < 2; ++n) _Pragma("unroll") for (int k = 0; k < 2; ++k) \
        acc[ai][bj][m][n] = __builtin_amdgcn_mfma_f32_16x16x32_bf16(Bt[n][k], At[m][k], acc[ai][bj][m][n], 0, 0, 0); __builtin_amdgcn_s_setprio(0); } while (0)
#define PG8_WAIT_V(n) asm volatile("s_waitcnt vmcnt(" #n ")" ::: "memory")
#define PG8_WAIT_L(n) asm volatile("s_waitcnt lgkmcnt(" #n ")" ::: "memory")
#define PG8_BAR __builtin_amdgcn_s_barrier()
#define PG8_SCHED __builtin_amdgcn_sched_barrier(0)
    Unit cur, nxt; int ui = 0;
    if (!S.next(0, cur)) return;
    f32x4 acc[2][2][4][2];
#pragma unroll
    for (int a = 0; a < 2; ++a)
#pragma unroll
        for (int b = 0; b < 2; ++b)
#pragma unroll
            for (int m = 0; m < 4; ++m)
#pragma unroll
                for (int n = 0; n < 2; ++n) acc[a][b][m][n] = (f32x4){0.f, 0.f, 0.f, 0.f};
    bf16x8 At[4][2], B0[2][2], B1[2][2];
    const char* cA = (const char*)g.A + (size_t)cur.pm * tstep; const char* cB = (const char*)g.Bt + (size_t)cur.pn * tstep;
    PG8_STAGE(PG8_SB(0, 0), cB, voffB); PG8_STAGE(PG8_SA(0, 0), cA, voffA); PG8_STAGE(PG8_SB(0, 1), cB + hstep, voffB); PG8_STAGE(PG8_SA(0, 1), cA + hstep, voffA);
    if (wr == 1) PG8_BAR;
    PG8_WAIT_V(4); PG8_BAR;
    PG8_STAGE(PG8_SB(1, 0), cB + kstep, voffB); PG8_STAGE(PG8_SA(1, 0), cA + kstep, voffA); PG8_STAGE(PG8_SB(1, 1), cB + hstep + kstep, voffB);
    PG8_WAIT_V(6); PG8_BAR;
    for (;;) {
        const bool has_next = S.next(ui + 1, nxt);
        const char* nA = has_next ? (const char*)g.A + (size_t)nxt.pm * tstep : cA; const char* nB = has_next ? (const char*)g.Bt + (size_t)nxt.pn * tstep : cB;
        for (int t = 0; t < nt; t += 2) {
            const bool last = (t == nt - 2);
            const char* a1 = cA + (size_t)(t + 1) * kstep;
            const char* a2 = last ? nA : cA + (size_t)(t + 2) * kstep; const char* b2 = last ? nB : cB + (size_t)(t + 2) * kstep;
            const char* a3 = a2 + kstep; const char* b3 = b2 + kstep;
            PG8_LDB(B0, 0, 0); PG8_SCHED; PG8_LDA(At, 0, 0); PG8_STAGE(PG8_SA(1, 1), a1 + hstep, voffA);
            PG8_WAIT_L(8); PG8_BAR; PG8_WAIT_L(0); PG8_MMA(0, 0, At, B0); PG8_BAR; PG8_SCHED;
            PG8_LDB(B1, 0, 1); PG8_STAGE(PG8_SB(0, 0), b2, voffB);
            PG8_BAR; PG8_WAIT_L(0); PG8_MMA(0, 1, At, B1); PG8_BAR;
            PG8_LDA(At, 0, 1); PG8_STAGE(PG8_SA(0, 0), a2, voffA);
            PG8_BAR; PG8_WAIT_L(0); PG8_MMA(1, 0, At, B0); PG8_BAR; PG8_SCHED;
            PG8_STAGE(PG8_SB(0, 1), b2 + hstep, voffB);
            PG8_WAIT_V(6); PG8_BAR; PG8_MMA(1, 1, At, B1); PG8_BAR;
            PG8_LDB(B0, 1, 0); PG8_SCHED; PG8_LDA(At, 1, 0); PG8_STAGE(PG8_SA(0, 1), a2 + hstep, voffA);
            PG8_WAIT_L(8); PG8_BAR; PG8_WAIT_L(0); PG8_MMA(0, 0, At, B0); PG8_BAR; PG8_SCHED;
            PG8_LDB(B1, 1, 1); PG8_STAGE(PG8_SB(1, 0), b3, voffB);
            PG8_BAR; PG8_WAIT_L(0); PG8_MMA(0, 1, At, B1); PG8_BAR;
            PG8_LDA(At, 1, 1); PG8_STAGE(PG8_SA(1, 0), a3, voffA);
            PG8_BAR; PG8_WAIT_L(0); PG8_MMA(1, 0, At, B0); PG8_BAR; PG8_SCHED;
            PG8_STAGE(PG8_SB(1, 1), b3 + hstep, voffB);
            PG8_WAIT_V(6); PG8_BAR; PG8_MMA(1, 1, At, B1); PG8_BAR;
        }
        E(acc, cur, wr, wc, fr, fq);
        if (!has_next) break;
#pragma unroll
        for (int a = 0; a < 2; ++a)
#pragma unroll
            for (int b = 0; b < 2; ++b)
#pragma unroll
                for (int m = 0; m < 4; ++m)
#pragma unroll
                    for (int n = 0; n < 2; ++n) acc[a][b][m][n] = (f32x4){0.f, 0.f, 0.f, 0.f};
        cur = nxt; cA = nA; cB = nB; ++ui;
    }
    PG8_WAIT_V(0);
    if (wr == 0) PG8_BAR;
    PG8_BAR;
#undef PG8_SA
#undef PG8_SB
#undef PG8_STAGE
#undef PG8_LDA
#undef PG8_LDB
#undef PG8_MMA
#undef PG8_WAIT_V
#undef PG8_WAIT_L
#undef PG8_BAR
#undef PG8_SCHED
}
}

DI void st_bf4(u16* dst, float a, float b, float c, float d) { uint2 u = {pk2(a, b), pk2(c, d)}; *(uint2*)dst = u; }
DI void st_bf8(u16* dst, const float (&v)[8]) { uint4 u = {pk2(v[0], v[1]), pk2(v[2], v[3]), pk2(v[4], v[5]), pk2(v[6], v[7])}; *(uint4*)dst = u; }

DI void epi_in8(const Params& p, float (&v)[8], int f0, int tok) {
    if (f0 >= 4248) return;
    u16* P = (u16*)(p.ws + OFF_P);
    const bool is_ctx = tok >= NLAT;
    int b, t, kvpos;
    if (!is_ctx) { b = tok >> 12; t = tok & 4095; kvpos = t; } else { int cc = tok - NLAT; b = cc >> 8; t = cc & 255; kvpos = SEQ + t; }
    kvpos = (kvpos & ~15) | (kvpos & 3) | (((kvpos >> 2) & 1) << 3) | (((kvpos >> 3) & 1) << 2);
    if (f0 < 384 || (f0 >= 768 && f0 < 1536)) {
        if (!is_ctx) {
            const float* cs;
            if (f0 < 384) { const int pp = f0 & 63; const int pos = pp < 32 ? (t >> 6) : (t & 63); cs = (const float*)(p.ws + OFF_TABA) + (pos * 16 + ((pp & 31) >> 1)) * 2; }
            else { const int pp = f0 & 31; const int pos = pp < 16 ? (t >> 6) : (t & 63); cs = (const float*)(p.ws + OFF_TABB) + (pos * 8 + ((pp & 15) >> 1)) * 2; }
            const float4 c0 = *(const float4*)cs, c1 = *(const float4*)(cs + 4);
            float o;
            o = v[0] * c0.x - v[1] * c0.y; v[1] = v[1] * c0.x + v[0] * c0.y; v[0] = o;
            o = v[2] * c0.z - v[3] * c0.w; v[3] = v[3] * c0.z + v[2] * c0.w; v[2] = o;
            o = v[4] * c1.x - v[5] * c1.y; v[5] = v[5] * c1.x + v[4] * c1.y; v[4] = o;
            o = v[6] * c1.z - v[7] * c1.w; v[7] = v[7] * c1.z + v[6] * c1.w; v[6] = o;
        }
        st_bf8(P + (size_t)tok * PC + (f0 < 384 ? f0 : f0 - 128), v);
    } else if (f0 < 512 || (f0 >= 1536 && f0 < 1920) || (f0 >= 3072 && f0 < 3456)) {
        u16* T; int d0;
        if (f0 < 512) { d0 = (f0 - 384) & 63; T = (u16*)(p.ws + OFF_VAT) + ((size_t)(b * 2 + ((f0 - 384) >> 6)) * 64) * KVS; }
        else if (f0 < 1920) { d0 = (f0 - 1536) & 63; T = (u16*)(p.ws + OFF_VBT) + ((size_t)(b * 6 + ((f0 - 1536) >> 6)) * 64) * KVS; }
        else { d0 = (f0 - 3072) & 63; T = (u16*)(p.ws + OFF_VMT) + ((size_t)(b * 6 + ((f0 - 3072) >> 6)) * 64) * KVS; }
#pragma unroll
        for (int e = 0; e < 8; ++e) T[(size_t)(d0 + e) * KVS + kvpos] = f2bf(v[e]);
    } else if (f0 < 768) {
        st_bf8(P + (size_t)tok * PC + (f0 - 128), v);
    } else if (f0 < 3072) {
        st_bf8(P + (size_t)tok * PC + (f0 - 512), v);
        if (f0 >= 2688) {
            const int d0 = (f0 - 2688) & 63;
            u16* T = (u16*)(p.ws + OFF_KMT) + ((size_t)(b * 6 + ((f0 - 2688) >> 6)) * 64) * KVS;
#pragma unroll
            for (int e = 0; e < 8; ++e) T[(size_t)(d0 + e) * KVS + kvpos] = f2bf(v[e]);
        }
    } else if (f0 < 4224) {
        st_bf8(P + (size_t)tok * PC + (f0 - 896), v);
    } else {
        float* G = (float*)(p.ws + OFF_G) + (size_t)tok * 24 + (f0 - 4224);
        *(float4*)G = make_float4(v[0], v[1], v[2], v[3]); *(float4*)(G + 4) = make_float4(v[4], v[5], v[6], v[7]);
    }
}

struct EpiIn {
    static constexpr bool PERM = true;
    const Params* pp;
    DI void operator()(const pg8::f32x4 (&acc)[2][2][4][2], const pg8::Unit& u, int wr, int wc, int fr, int fq) const {
#pragma unroll
        for (int ai = 0; ai < 2; ++ai)
#pragma unroll
            for (int m = 0; m < 4; ++m) {
                const int tok = u.pm * 256 + ai * 128 + wr * 64 + m * 16 + fr;
#pragma unroll
                for (int bj = 0; bj < 2; ++bj) {
                    const int f0 = u.pn * 256 + bj * 128 + wc * 32 + 8 * fq;
                    float v[8];
#pragma unroll
                    for (int e = 0; e < 4; ++e) { v[e] = acc[ai][bj][m][0][e]; v[4 + e] = acc[ai][bj][m][1][e]; }
                    epi_in8(*pp, v, f0, tok);
                }
            }
    }
};

struct EpiOut {
    static constexpr bool PERM = false;
    const Params* pp; int layer;
    DI void operator()(const pg8::f32x4 (&acc)[2][2][4][2], const pg8::Unit& u, int wr, int wc, int fr, int fq) const {
        const Params& p = *pp;
        const float* MOD = (const float*)(p.ws + OFF_MOD);
#pragma unroll
        for (int ai = 0; ai < 2; ++ai)
#pragma unroll
            for (int m = 0; m < 4; ++m) {
                const int tok = u.pm * 256 + ai * 128 + wr * 64 + m * 16 + fr;
                const bool is_ctx = tok >= NLAT;
                const float* src; float* dst; int r;
                if (!is_ctx) { r = tok >> 12; src = (layer == 0 ? p.x : p.out) + (size_t)tok * 1024; dst = p.out + (size_t)tok * 1024; }
                else { r = 8; float* xc = (float*)(p.ws + OFF_XC) + (size_t)(tok - NLAT) * 1024; src = layer == 0 ? p.ctx + (size_t)(tok - NLAT) * 1024 : xc; dst = xc; }
                const float* gate = MOD + ((size_t)layer * 9 + r) * 3072 + 2048;
#pragma unroll
                for (int bj = 0; bj < 2; ++bj)
#pragma unroll
                    for (int n = 0; n < 2; ++n) {
                        const int col = u.pn * 256 + bj * 128 + wc * 32 + 16 * n + 4 * fq;
                        const float4 xv = *(const float4*)(src + col), gv = *(const float4*)(gate + col);
                        float4 o;
                        o.x = ALPHA * xv.x + gv.x * acc[ai][bj][m][n][0]; o.y = ALPHA * xv.y + gv.y * acc[ai][bj][m][n][1];
                        o.z = ALPHA * xv.z + gv.z * acc[ai][bj][m][n][2]; o.w = ALPHA * xv.w + gv.w * acc[ai][bj][m][n][3];
                        *(float4*)(dst + col) = o;
                    }
            }
    }
};

DI void phase_gemm_in(const Params& p, int layer, unsigned char* dyn_lds, int wid) {
    pg8::Gemm g{(const u16*)(p.ws + OFF_HY), (const u16*)(p.ws + OFF_WI) + (size_t)layer * NPAD * LDK, NTOK, NPAD, 1024};
    pg8::StaticOrder S; S.init(NTOK, NPAD, (int)gridDim.x, (int)blockIdx.x);
    EpiIn E{&p};
    pg8::gemm_phase<EpiIn>((PG8_LAS unsigned char*)dyn_lds, g, S, E, wid);
}
DI void phase_gemm_out(const Params& p, int layer, unsigned char* dyn_lds, int wid) {
    const int M = layer == DEPTH - 1 ? NLAT : NTOK;
    pg8::Gemm g{(const u16*)(p.ws + OFF_HY), (const u16*)(p.ws + OFF_WO) + (size_t)layer * 1024 * LDK, M, 1024, 1024};
    pg8::StaticOrder S; S.init(M, 1024, (int)gridDim.x, (int)blockIdx.x);
    EpiOut E{&p, layer};
    pg8::gemm_phase<EpiOut>((PG8_LAS unsigned char*)dyn_lds, g, S, E, wid);
}

constexpr int AST = 72;

template <int NS>
DI void attn_item(const Params& p, int layer, char* smem, VBC& vc, int b, int hq, int qblk) {
    constexpr int DQK = 64 / NS, NKS = DQK / 16;
    const u16* P = (const u16*)(p.ws + OFF_P);
    u16* Y = (u16*)(p.ws + OFF_HY);
    const int tid = opaque_tid(vc), lane = tid & 63, wave = tid >> 6, r = lane & 31, h = lane >> 5;
    u16* sK = (u16*)smem;
    const bool qctx = qblk >= 32;
    const int qrow0 = qctx ? NLAT + b * CTXL + (qblk - 32) * 128 : b * SEQ + qblk * 128;
    const int qcol = NS == 1 ? P_QA + hq * 64 : P_QB + hq * 64;
    const int kcol = NS == 1 ? P_KA + (hq >> 1) * 64 : P_KB + hq * 64;
    const u16* VT = NS == 1 ? (const u16*)(p.ws + OFF_VAT) + ((size_t)(b * 2 + (hq >> 1)) * 64) * KVS
                            : (const u16*)(p.ws + OFF_VBT) + ((size_t)(b * 6 + hq) * 64) * KVS;
    int lat0, lat1;
    if (qctx) { lat0 = 0; lat1 = 0; }
    else if (NS == 1) { lat0 = max(0, (qblk - 1) * 2); lat1 = min(64, (qblk + 2) * 2); }
    else { lat0 = 0; lat1 = 64; }
    const int ntiles = (lat1 - lat0) + 4;
    const int qpos = qblk * 128 + wave * 32 + r;
    bf16x8 qf[NS][NKS];
    {
        const u16* qp = P + (size_t)(qrow0 + wave * 32 + r) * PC + qcol + h * 8;
#pragma unroll
        for (int m = 0; m < NS; ++m)
#pragma unroll
            for (int ks = 0; ks < NKS; ++ks) qf[m][ks] = ld8(qp + m * DQK + ks * 16);
    }
    const float cexp = 1.f;
    float mrun[NS], lrun[NS];
    f32x16 O[NS][2];
    unsigned qaug[NS];
    auto init_state = [&]() {
#pragma unroll
        for (int m = 0; m < NS; ++m) {
            if (NS == 1) { mrun[m] = p.sink[layer * 4 + hq] * LOG2E; lrun[m] = h == 0 ? 1.f : 0.f; }
            else { mrun[m] = -1e30f; lrun[m] = 0.f; }
            qaug[m] = 0u;
#pragma unroll
            for (int t = 0; t < 2; ++t)
#pragma unroll
                for (int e = 0; e < 16; ++e) O[m][t][e] = 0.f;
        }
    };
    init_state();
    const int wave4 = tid >> 6;
    const int drow = lane >> 3, dslot = lane & 7;
    auto tile_ptrs = [&](int it, const u16*& kp, const u16*& vp) {
        if (it < lat1 - lat0) { int kt = lat0 + it; kp = P + (size_t)(b * SEQ + kt * 64) * PC + kcol; vp = VT + kt * 64; }
        else { int c = it - (lat1 - lat0); kp = P + (size_t)(NLAT + b * CTXL + c * 64) * PC + kcol; vp = VT + SEQ + c * 64; }
    };
    auto dma_tile = [&](int it, int st) {
        const u16 *kp, *vp; tile_ptrs(it, kp, vp);
#pragma unroll
        for (int i = 0; i < 2; ++i) {
            const int row = wave4 * 16 + i * 8 + drow;
            const int chunk = dslot ^ ((row >> 1) & 7);
            lds_u32* dk = (lds_u32*)(sK + st * 8192 + (wave4 * 16 + i * 8) * 64);
            lds_u32* dv = (lds_u32*)(sK + st * 8192 + 4096 + (wave4 * 16 + i * 8) * 64);
            __builtin_amdgcn_global_load_lds((const unsigned*)(kp + (size_t)row * PC + chunk * 8), dk, 16, 0, 0);
            __builtin_amdgcn_global_load_lds((const unsigned*)(vp + (size_t)row * KVS + chunk * 8), dv, 16, 0, 0);
        }
    };
    const int hs16 = ((h ^ ((r >> 1) & 7)) << 3);
    const bf16x8 kones = __builtin_bit_cast(bf16x8, (uint4){0x00003F80u, 0u, 0u, 0u});
    auto run_tiles = [&](const bool fast) {
    dma_tile(0, 0);
    asm volatile("s_waitcnt vmcnt(0)" ::: "memory");
    VSYNC();
    for (int it = 0; it < ntiles; ++it) {
        const int buf = it & 1;
        if (it + 1 < ntiles) dma_tile(it + 1, buf ^ 1);
        const u16* cK = sK + buf * 8192; const u16* cV = cK + 4096;
        const bool is_lat = it < lat1 - lat0;
        const int kpos0 = (lat0 + it) * 64;
        auto qk = [&](const int m, f32x16 (&s)[2]) {
#pragma unroll
            for (int kt2 = 0; kt2 < 2; ++kt2)
#pragma unroll
                for (int e = 0; e < 16; ++e) s[kt2][e] = 0.f;
            __builtin_amdgcn_s_setprio(1);
#pragma unroll
            for (int ks = 0; ks < NKS; ++ks)
#pragma unroll
                for (int kt2 = 0; kt2 < 2; ++kt2) s[kt2] = MFMA(ld8(cK + (kt2 * 32 + r) * 64 + (((m * DQK + ks * 16)) ^ hs16)), qf[m][ks], s[kt2]);
#pragma unroll
            for (int kt2 = 0; kt2 < 2; ++kt2) { uint4 qa4 = {qaug[m], 0u, 0u, 0u}; s[kt2] = MFMA(kones, __builtin_bit_cast(bf16x8, qa4), s[kt2]); }
            __builtin_amdgcn_s_setprio(0);
        };
        auto softmax = [&](const int m, f32x16 (&s)[2], bf16x8 (&pf)[2][2]) {
            const bool fixed = fast && it > 0;
            if (NS == 1 && is_lat) {
#pragma unroll
                for (int kt2 = 0; kt2 < 2; ++kt2)
#pragma unroll
                    for (int e = 0; e < 16; ++e) {
                        int d = kpos0 + kt2 * 32 + crow(e, h) - qpos;
                        if (d > 128 || d < -128) s[kt2][e] = -1e30f;
                    }
            }
            if (fixed) {
                float ls = 0.f;
#pragma unroll
                for (int kt2 = 0; kt2 < 2; ++kt2)
#pragma unroll
                    for (int e = 0; e < 16; ++e) { const float pv = __builtin_amdgcn_exp2f(s[kt2][e]); s[kt2][e] = pv; ls += pv; }
                lrun[m] += ls;
            } else {
                float tmax = -1e30f;
    #pragma unroll
                for (int kt2 = 0; kt2 < 2; ++kt2)
    #pragma unroll
                    for (int e = 0; e < 16; ++e) tmax = fmaxf(tmax, s[kt2][e]);
                tmax = fmaxf(tmax, __shfl_xor(tmax, 32));
                float mnew = fmaxf(mrun[m], tmax * cexp);
                if (fast) mnew = bf2f(f2bf(mnew));
                const float alpha = __builtin_amdgcn_exp2f(mrun[m] - mnew);
                mrun[m] = mnew;
                f32x2 ls2 = {0.f, 0.f};
                const f32x2 cc2 = {cexp, cexp}, mm2 = {-mnew, -mnew};
    #pragma unroll
                for (int kt2 = 0; kt2 < 2; ++kt2)
    #pragma unroll
                    for (int e = 0; e < 16; e += 2) {
                        f32x2 sv = {s[kt2][e], s[kt2][e + 1]};
                        sv = __builtin_elementwise_fma(sv, cc2, mm2);
                        f32x2 pv = {__builtin_amdgcn_exp2f(sv.x), __builtin_amdgcn_exp2f(sv.y)};
                        s[kt2][e] = pv.x; s[kt2][e + 1] = pv.y; ls2 += pv;
                    }
                lrun[m] = lrun[m] * alpha + (ls2.x + ls2.y);
                if (__any(alpha != 1.f)) {
    #pragma unroll
                    for (int t = 0; t < 2; ++t)
    #pragma unroll
                        for (int e = 0; e < 16; ++e) O[m][t][e] *= alpha;
                }
                if (fast) {
                    qaug[m] = h == 0 ? (unsigned)f2bf(-mrun[m]) : 0u;
                }
            }
#pragma unroll
            for (int kt2 = 0; kt2 < 2; ++kt2) { pf[kt2][0] = pack8(s[kt2], 0); pf[kt2][1] = pack8(s[kt2], 1); }
        };
        auto pvm = [&](const int m, const bf16x8 (&pf)[2][2]) {
            __builtin_amdgcn_s_setprio(1);
#pragma unroll
            for (int kk = 0; kk < 4; ++kk)
#pragma unroll
                for (int dvt = 0; dvt < 2; ++dvt) O[m][dvt] = MFMA(ld8(cV + (dvt * 32 + r) * 64 + ((kk * 16) ^ hs16)), pf[kk >> 1][kk & 1], O[m][dvt]);
            __builtin_amdgcn_s_setprio(0);
        };
        {
            f32x16 sa[2]; bf16x8 pfa[2][2];
            qk(0, sa);
            __builtin_amdgcn_sched_barrier(0);
            softmax(0, sa, pfa);
            __builtin_amdgcn_sched_barrier(0);
            if (NS == 2) {
                f32x16 sb[2]; bf16x8 pfb[2][2];
                qk(NS - 1, sb);
                pvm(0, pfa);
                softmax(NS - 1, sb, pfb);
                __builtin_amdgcn_sched_barrier(0);
                pvm(NS - 1, pfb);
            } else {
                pvm(0, pfa);
            }
            __builtin_amdgcn_sched_barrier(0);
        }
        asm volatile("s_waitcnt vmcnt(0)" ::: "memory");
        VSYNC();
    }
    };
    for (int attempt = 0; attempt < 2; ++attempt) {
        if (attempt) init_state();
        run_tiles(attempt == 0);
        bool bad = !(lrun[0] < 1e37f);
        if (NS == 2) bad = bad || !(lrun[NS - 1] < 1e37f);
        int* flag = vc.mail;
        if (tid == 0) *flag = 0;
        VSYNC();
        if (bad) *flag = 1;
        VSYNC();
        const int redo = *flag;
        VSYNC();
        if (!redo) break;
    }
    const int tok = qrow0 + wave * 32 + r;
    if (NS == 1) {
        float l = lrun[0] + __shfl_xor(lrun[0], 32);
        const float inv = 1.f / l;
        const u16* zp = P + (size_t)tok * PC + P_ZA + hq * 64;
        u16* yp = Y + (size_t)tok * LDK + hq * 64;
#pragma unroll
        for (int t = 0; t < 2; ++t)
#pragma unroll
            for (int g = 0; g < 4; ++g) {
                const int dv = t * 32 + 8 * g + 4 * h;
                uint2 z = *(const uint2*)(zp + dv);
                st_bf4(yp + dv, O[0][t][4 * g] * inv * silu_f(bflo(z.x)), O[0][t][4 * g + 1] * inv * silu_f(bfhi(z.x)),
                       O[0][t][4 * g + 2] * inv * silu_f(bflo(z.y)), O[0][t][4 * g + 3] * inv * silu_f(bfhi(z.y)));
            }
    } else {
        const float* L = (const float*)(p.ws + OFF_LAM);
        const float lam = L[layer * 2], lam_init = L[layer * 2 + 1];
        float l0 = lrun[0] + __shfl_xor(lrun[0], 32), l1 = lrun[NS - 1] + __shfl_xor(lrun[NS - 1], 32);
        const float i0 = 1.f / l0, i1 = lam / l1;
        float ss = 0.f;
#pragma unroll
        for (int t = 0; t < 2; ++t)
#pragma unroll
            for (int e = 0; e < 16; ++e) { float o = O[0][t][e] * i0 - O[NS - 1][t][e] * i1; O[0][t][e] = o; ss += o * o; }
        ss += __shfl_xor(ss, 32);
        const float rs = rsqrtf(ss * (1.f / 64.f) + LN_EPS) * (1.f - lam_init);
        const u16* zp = P + (size_t)tok * PC + P_ZB + hq * 64;
        u16* yp = Y + (size_t)tok * LDK + 256 + hq * 64;
        const float* gn = p.dng + layer * 64;
#pragma unroll
        for (int t = 0; t < 2; ++t)
#pragma unroll
            for (int g = 0; g < 4; ++g) {
                const int dv = t * 32 + 8 * g + 4 * h;
                uint2 z = *(const uint2*)(zp + dv);
                float4 gv = *(const float4*)(gn + dv);
                st_bf4(yp + dv, O[0][t][4 * g] * rs * gv.x * silu_f(bflo(z.x)), O[0][t][4 * g + 1] * rs * gv.y * silu_f(bfhi(z.x)),
                       O[0][t][4 * g + 2] * rs * gv.z * silu_f(bflo(z.y)), O[0][t][4 * g + 3] * rs * gv.w * silu_f(bfhi(z.y)));
            }
    }
}

DI float logsig(float x) { return fminf(x, 0.f) - log1pf(__expf(-fabsf(x))); }

DI void mlstm_chain(const Params& p, int layer, char* smem, VBC& vc, int chain) {
    const int b = chain / 12, rem = chain % 12, hd = rem >> 1, dir = rem & 1;
    const u16* P = (const u16*)(p.ws + OFF_P);
    const float* G = (const float*)(p.ws + OFF_G);
    const u16* KT = (const u16*)(p.ws + OFF_KMT) + ((size_t)(b * 6 + hd) * 64) * KVS;
    const u16* VT = (const u16*)(p.ws + OFF_VMT) + ((size_t)(b * 6 + hd) * 64) * KVS;
    u16* HD = (u16*)(p.ws + OFF_HD) + (size_t)dir * NTOK * 384;
    const int tid = opaque_tid(vc), lane = tid & 63, wave = tid >> 6, r = lane & 31, h = lane >> 5, tt = wave & 1, vh = wave >> 1;
    u16* sQ = (u16*)smem; u16* sK = sQ + 64 * AST; u16* sKT = sK + 64 * AST; u16* sVT = sKT + 64 * AST;
    float* fl = (float*)(sVT + 64 * AST);
    float *s_ig = fl, *s_fg = fl + 64, *s_b = fl + 128, *s_a = fl + 192, *s_mt = fl + 256, *s_wi = fl + 320, *s_w = fl + 384, *s_nq = fl + 448, *s_n = fl + 512, *s_sc = fl + 576;
    const float ibias = p.ib[layer * 12 + dir * 6 + hd], fbias = p.fb[layer * 12 + dir * 6 + hd];
    f32x16 Cst[2];
#pragma unroll
    for (int t = 0; t < 2; ++t)
#pragma unroll
        for (int e = 0; e < 16; ++e) Cst[t][e] = 0.f;
    float m_state = 0.f, n_reg = 0.f;
    if (tid < 64) s_n[tid] = 0.f;
    const int lrow = tid >> 3, lpart = tid & 7;
    uint4 rq0, rq1, rk0, rk1, rkt0, rkt1, rvt0, rvt1; float rgi = 0.f, rgf = 0.f;
    auto chunk_pos = [&](int step, int& prow0, int& kv0) {
        if (step < 4) { int j = dir ? 3 - step : step; prow0 = NLAT + b * CTXL + j * 64; kv0 = SEQ + j * 64; }
        else { int c = dir ? 63 - (step - 4) : step - 4; prow0 = b * SEQ + c * 64; kv0 = c * 64; }
    };
    auto issue = [&](int step) {
        int prow0, kv0; chunk_pos(step, prow0, kv0);
        const u16* qp = P + (size_t)(prow0 + lrow) * PC + P_QM + hd * 64 + lpart * 8;
        rq0 = *(const uint4*)qp; rq1 = *(const uint4*)(qp + (size_t)32 * PC);
        const u16* kp = P + (size_t)(prow0 + lrow) * PC + P_KM + hd * 64 + lpart * 8;
        rk0 = *(const uint4*)kp; rk1 = *(const uint4*)(kp + (size_t)32 * PC);
        const u16* ktp = KT + (size_t)lrow * KVS + kv0 + lpart * 8;
        rkt0 = *(const uint4*)ktp; rkt1 = *(const uint4*)(ktp + (size_t)32 * KVS);
        const u16* vtp = VT + (size_t)lrow * KVS + kv0 + lpart * 8;
        rvt0 = *(const uint4*)vtp; rvt1 = *(const uint4*)(vtp + (size_t)32 * KVS);
        if (tid < 64) { const float* g = G + (size_t)(prow0 + tid) * 24 + dir * 12 + hd; rgi = g[0]; rgf = g[6]; }
    };
    issue(0);
    for (int step = 0; step < 68; ++step) {
        int prow0, kv0; chunk_pos(step, prow0, kv0);
        *(uint4*)(sQ + lrow * AST + lpart * 8) = rq0; *(uint4*)(sQ + (lrow + 32) * AST + lpart * 8) = rq1;
        *(uint4*)(sK + lrow * AST + lpart * 8) = rk0; *(uint4*)(sK + (lrow + 32) * AST + lpart * 8) = rk1;
        *(uint4*)(sKT + lrow * AST + lpart * 8) = rkt0; *(uint4*)(sKT + (lrow + 32) * AST + lpart * 8) = rkt1;
        *(uint4*)(sVT + lrow * AST + lpart * 8) = rvt0; *(uint4*)(sVT + (lrow + 32) * AST + lpart * 8) = rvt1;
        if (tid < 64) { s_ig[tid] = rgi + ibias; s_fg[tid] = logsig(rgf + fbias); }
        VSYNC();
        if (step + 1 < 68) issue(step + 1);
        if (wave == 0) {
            const float ig = s_ig[lane], lf = s_fg[lane];
            float bb = lf;
#pragma unroll
            for (int off = 1; off < 64; off <<= 1) {
                float v = dir ? __shfl_down(bb, off) : __shfl_up(bb, off);
                bool ok = dir ? (lane + off < 64) : (lane >= off);
                if (ok) bb += v;
            }
            const float aa = ig - bb;
            float cm = aa;
#pragma unroll
            for (int off = 1; off < 64; off <<= 1) {
                float v = dir ? __shfl_down(cm, off) : __shfl_up(cm, off);
                bool ok = dir ? (lane + off < 64) : (lane >= off);
                if (ok) cm = fmaxf(cm, v);
            }
            const float mt = fmaxf(bb + m_state, bb + cm);
            const float wi = __expf(bb + m_state - mt);
            const float b_last = __shfl(bb, dir ? 0 : 63);
            const float amax = wave_max(aa);
            const float m_new = fmaxf(b_last + m_state, b_last + amax);
            const float w = __expf(b_last + aa - m_new);
            const float decay = __expf(b_last + m_state - m_new);
            s_w[lane] = w;
            float nq = 0.f;
#pragma unroll
            for (int d8 = 0; d8 < 8; ++d8) {
                uint4 qv = *(const uint4*)(sQ + lane * AST + d8 * 8);
                float4 n0 = *(const float4*)(s_n + d8 * 8), n1 = *(const float4*)(s_n + d8 * 8 + 4);
                nq += bflo(qv.x) * n0.x + bfhi(qv.x) * n0.y + bflo(qv.y) * n0.z + bfhi(qv.y) * n0.w
                    + bflo(qv.z) * n1.x + bfhi(qv.z) * n1.y + bflo(qv.w) * n1.z + bfhi(qv.w) * n1.w;
            }
            float nacc = 0.f;
#pragma unroll
            for (int s8 = 0; s8 < 8; ++s8) {
                uint4 kv = *(const uint4*)(sKT + lane * AST + s8 * 8);
                float4 w0 = *(const float4*)(s_w + (s8 >> 1) * 16 + 4 * (s8 & 1)), w1 = *(const float4*)(s_w + (s8 >> 1) * 16 + 8 + 4 * (s8 & 1));
                nacc += bflo(kv.x) * w0.x + bfhi(kv.x) * w0.y + bflo(kv.y) * w0.z + bfhi(kv.y) * w0.w
                      + bflo(kv.z) * w1.x + bfhi(kv.z) * w1.y + bflo(kv.w) * w1.z + bfhi(kv.w) * w1.w;
            }
            n_reg = decay * n_reg + nacc;
            s_b[lane] = bb; s_a[lane] = aa; s_mt[lane] = mt; s_wi[lane] = wi; s_nq[lane] = nq; s_n[lane] = n_reg;
            if (lane == 0) s_sc[0] = decay;
            m_state = m_new;
        }
        VSYNC();
        {
            const int t = tt * 32 + r;
            const float bt = s_b[t], mtt = s_mt[t], wit = s_wi[t];
            bf16x8 qfr[4];
#pragma unroll
            for (int ks = 0; ks < 4; ++ks) qfr[ks] = ld8(sQ + t * AST + ks * 16 + h * 8);
            bf16x8 pf[2][2];
            float dsum = 0.f;
            {
                f32x16 sx[2];
#pragma unroll
                for (int si = 0; si < 2; ++si)
#pragma unroll
                    for (int e = 0; e < 16; ++e) sx[si][e] = 0.f;
#pragma unroll
                for (int ks = 0; ks < 4; ++ks)
#pragma unroll
                    for (int si = 0; si < 2; ++si) sx[si] = MFMA(ld8(sK + (si * 32 + r) * AST + ks * 16 + h * 8), qfr[ks], sx[si]);
#pragma unroll
                for (int si = 0; si < 2; ++si) {
#pragma unroll
                    for (int e = 0; e < 16; ++e) {
                        const int sidx = si * 32 + crow(e, h);
                        const bool valid = dir ? (sidx >= t) : (sidx <= t);
                        const float dm = valid ? __expf(bt + s_a[sidx] - mtt) : 0.f;
                        const float pv = sx[si][e] * dm; sx[si][e] = pv; dsum += pv;
                    }
                    pf[si][0] = pack8(sx[si], 0); pf[si][1] = pack8(sx[si], 1);
                }
            }
            dsum += __shfl_xor(dsum, 32);
            f32x16 Z;
#pragma unroll
            for (int e = 0; e < 16; ++e) Z[e] = 0.f;
#pragma unroll
            for (int dt = 0; dt < 2; ++dt)
#pragma unroll
                for (int sp = 0; sp < 2; ++sp) {
                    const u16* qp = sQ + t * AST + dt * 32 + sp * 16 + 4 * h;
                    Z = MFMA(pack8(Cst[dt], sp), ld4x2(qp, qp + 8), Z);
                }
#pragma unroll
            for (int e = 0; e < 16; ++e) Z[e] *= wit;
#pragma unroll
            for (int kk = 0; kk < 4; ++kk) {
                const int si = kk >> 1, sp = kk & 1;
                Z = MFMA(ld8(sVT + (vh * 32 + r) * AST + si * 32 + sp * 16 + 8 * h), pf[si][sp], Z);
            }
            const float den = wit * s_nq[t] + dsum;
            const float inv = 1.f / fmaxf(fabsf(den), __expf(-mtt));
            u16* hp = HD + (size_t)(prow0 + t) * 384 + hd * 64 + vh * 32 + 4 * h;
#pragma unroll
            for (int g = 0; g < 4; ++g) st_bf4(hp + 8 * g, Z[4 * g] * inv, Z[4 * g + 1] * inv, Z[4 * g + 2] * inv, Z[4 * g + 3] * inv);
            const float decay = s_sc[0];
            bf16x8 wv[4];
#pragma unroll
            for (int ks = 0; ks < 4; ++ks) {
                uint4 vv = *(const uint4*)(sVT + (vh * 32 + r) * AST + ks * 16 + h * 8);
                float4 w0 = *(const float4*)(s_w + ks * 16 + 4 * h), w1 = *(const float4*)(s_w + ks * 16 + 8 + 4 * h);
                uint4 u;
                u.x = pk2(bflo(vv.x) * w0.x, bfhi(vv.x) * w0.y); u.y = pk2(bflo(vv.y) * w0.z, bfhi(vv.y) * w0.w);
                u.z = pk2(bflo(vv.z) * w1.x, bfhi(vv.z) * w1.y); u.w = pk2(bflo(vv.w) * w1.z, bfhi(vv.w) * w1.w);
                wv[ks] = __builtin_bit_cast(bf16x8, u);
            }
#pragma unroll
            for (int dt = 0; dt < 2; ++dt)
#pragma unroll
                for (int e = 0; e < 16; ++e) Cst[dt][e] *= decay;
#pragma unroll
            for (int ks = 0; ks < 4; ++ks)
#pragma unroll
                for (int dt = 0; dt < 2; ++dt) Cst[dt] = MFMA(ld8(sKT + (dt * 32 + r) * AST + ks * 16 + h * 8), wv[ks], Cst[dt]);
        }
        VSYNC();
    }
}

DI void fin_item(const Params& p, int layer, int b, int hd, int quarter, bool with_ctx, int tid) {
    const u16* P = (const u16*)(p.ws + OFF_P);
    const u16* HF = (const u16*)(p.ws + OFF_HD); const u16* HB = HF + (size_t)NTOK * 384;
    u16* Y = (u16*)(p.ws + OFF_HY);
    const float* gn = p.mng + layer * 384;
    const int nlat = 1024, nctx = with_ctx ? 64 : 0;
    for (int i = tid; i < (nlat + nctx) * 16; i += 256) {
        const int tl = i >> 4, q = i & 15, col = hd * 64 + q * 4;
        const int tok = tl < nlat ? b * SEQ + quarter * 1024 + tl : NLAT + b * CTXL + quarter * 64 + (tl - nlat);
        uint2 a = *(const uint2*)(HF + (size_t)tok * 384 + col), bq = *(const uint2*)(HB + (size_t)tok * 384 + col);
        float s0 = bflo(a.x) + bflo(bq.x), s1 = bfhi(a.x) + bfhi(bq.x), s2 = bflo(a.y) + bflo(bq.y), s3 = bfhi(a.y) + bfhi(bq.y);
        float ss = s0 * s0 + s1 * s1 + s2 * s2 + s3 * s3;
        ss += __shfl_xor(ss, 1); ss += __shfl_xor(ss, 2); ss += __shfl_xor(ss, 4); ss += __shfl_xor(ss, 8);
        const float rs = rsqrtf(ss * (1.f / 64.f) + LN_EPS);
        float4 gv = *(const float4*)(gn + col);
        uint2 o = *(const uint2*)(P + (size_t)tok * PC + P_OM + col), z = *(const uint2*)(P + (size_t)tok * PC + P_ZM + col);
        st_bf4(Y + (size_t)tok * LDK + 640 + col,
               s0 * rs * gv.x * sigmoid_f(bflo(o.x)) * silu_f(bflo(z.x)), s1 * rs * gv.y * sigmoid_f(bfhi(o.x)) * silu_f(bfhi(z.x)),
               s2 * rs * gv.z * sigmoid_f(bflo(o.y)) * silu_f(bflo(z.y)), s3 * rs * gv.w * sigmoid_f(bfhi(o.y)) * silu_f(bfhi(z.y)));
    }
}
DI int next_item(int* ctr, int* s_item, VBC& vc) {
    if ((vc.wid & 3) == 0 && lane_id() == 0) *s_item = atomicAdd(ctr, 1);
    VSYNC();
    int item = *s_item;
    VSYNC();
    return item;
}
DI void phase_mix(const Params& p, int layer, char* smem, VBC& vc) {
    int* const s_item_p = vc.mail;
    const int xcd = blockIdx.x & 7;
    int* ctr = (int*)(p.ws + OFF_BAR) + BAR_MIXCTR_W + layer * 24 + xcd;
    unsigned* fin_ready = (unsigned*)(p.ws + OFF_BAR) + BAR_FINRDY_W + layer * 48;
    const bool with_ctx = layer < DEPTH - 1;
    if ((vc.wid >> 2) == 0 && blockIdx.x < 96) { __builtin_amdgcn_s_setprio(3); mlstm_chain(p, layer, smem, vc, blockIdx.x); __builtin_amdgcn_s_setprio(0);
        asm volatile("s_waitcnt vmcnt(0)" ::: "memory");
        VSYNC();
        if ((vc.wid & 3) == 0 && lane_id() == 0) {
            __builtin_amdgcn_fence(__ATOMIC_RELEASE, "agent");
            asm volatile("s_waitcnt vmcnt(0)" ::: "memory");
            __hip_atomic_fetch_add(fin_ready + (blockIdx.x >> 1), 1u, __ATOMIC_RELAXED, __HIP_MEMORY_SCOPE_AGENT);
        }
    }
    const int nB = 6 * 32, nBc = with_ctx ? 6 * 2 : 0;
    while (true) {
        int item = next_item(ctr, s_item_p, vc);
        if (item >= nB + nBc) break;
        int k, qb;
        if (item < nB) { k = item >> 5; qb = item & 31; } else { item -= nB; k = item >> 1; qb = 32 + (item & 1); }
        const int pb = xcd + 8 * k;
        attn_item<2>(p, layer, smem, vc, pb / 6, pb % 6, qb);
    }
    const int nA = 2 * 64, nAc = with_ctx ? 2 * 4 : 0;
    while (true) {
        int item = next_item(ctr + 8, s_item_p, vc);
        if (item >= nA + nAc) break;
        int k, hl, qb;
        if (item < nA) { k = item >> 6; hl = (item >> 5) & 1; qb = item & 31; } else { item -= nA; k = item >> 2; hl = (item >> 1) & 1; qb = 32 + (item & 1); }
        const int pk = xcd + 8 * k;
        attn_item<1>(p, layer, smem, vc, pk >> 1, 2 * (pk & 1) + hl, qb);
    }
    {
        const int tid = opaque_tid(vc);
        while (true) {
            const int item = next_item(ctr + 16, s_item_p, vc);
            if (item >= 24) break;
            const int pb = xcd + 8 * (item >> 2);
            if (tid == 0) {
                unsigned spins = 0;
                while (__hip_atomic_load(fin_ready + pb, __ATOMIC_RELAXED, __HIP_MEMORY_SCOPE_AGENT) < 2u && ++spins < (1u << 22)) __builtin_amdgcn_s_sleep(8);
                __builtin_amdgcn_fence(__ATOMIC_ACQUIRE, "agent");
                asm volatile("s_waitcnt vmcnt(0)" ::: "memory");
            }
            VSYNC();
            fin_item(p, layer, pb / 6, pb % 6, item & 3, with_ctx, tid);
        }
    }
}

DI void phase_ln(const Params& p, int layer, const VBC& vc) {
    const int nrows = layer < DEPTH - 1 ? NTOK : NLAT;
    const float* MOD = (const float*)(p.ws + OFF_MOD);
    u16* H = (u16*)(p.ws + OFF_HY);
    const float* g = p.ln_g + layer * 1024; const float* bta = p.ln_b + layer * 1024;
    const int tid = opaque_tid(vc);
    const int lane = tid & 63, gw = VBID * 4 + (tid >> 6), nw = VGRID * 4;
    for (int row = gw; row < nrows; row += nw) {
        float* xr = row < NLAT ? p.out + (size_t)row * 1024 : (float*)(p.ws + OFF_XC) + (size_t)(row - NLAT) * 1024;
        float4 v[4];
        float s = 0.f;
#pragma unroll
        for (int j = 0; j < 4; ++j) { v[j] = *(const float4*)(xr + lane * 4 + 256 * j); s += v[j].x + v[j].y + v[j].z + v[j].w; }
        const float mean = wave_sum(s) * (1.f / 1024.f);
        float q = 0.f;
#pragma unroll
        for (int j = 0; j < 4; ++j) { v[j].x -= mean; v[j].y -= mean; v[j].z -= mean; v[j].w -= mean; q += v[j].x * v[j].x + v[j].y * v[j].y + v[j].z * v[j].z + v[j].w * v[j].w; }
        const float rstd = rsqrtf(wave_sum(q) * (1.f / 1024.f) + LN_EPS);
        const int r = row < NLAT ? (row >> 12) : 8;
        const float* md = MOD + ((size_t)(layer + 1) * 9 + r) * 3072;
#pragma unroll
        for (int j = 0; j < 4; ++j) {
            const int n = lane * 4 + 256 * j;
            float4 gv = *(const float4*)(g + n), bv = *(const float4*)(bta + n), o;
            o.x = v[j].x * rstd * gv.x + bv.x; o.y = v[j].y * rstd * gv.y + bv.y; o.z = v[j].z * rstd * gv.z + bv.z; o.w = v[j].w * rstd * gv.w + bv.w;
            *(float4*)(xr + n) = o;
            if (layer < DEPTH - 1) {
                float4 sh = *(const float4*)(md + n), sc = *(const float4*)(md + 1024 + n);
                st_bf4(H + (size_t)row * LDK + n, o.x * (1.f + sc.x) + sh.x, o.y * (1.f + sc.y) + sh.y, o.z * (1.f + sc.z) + sh.z, o.w * (1.f + sc.w) + sh.w);
            }
        }
    }
}

constexpr int NPHASE = 2 + 5 * DEPTH;
#define XB_TMO      128
#define XB_XCNT(j)  (256  + 64 * (j))
#define XB_XSUB(j)  (1280 + 64 * (j))
#define XB_XGEN(j)  (2304 + 64 * (j))
#define XB_TOP      3328
#define XB_TOPGEN   3392
#define XB_SPIN_CAP (1u << 18)
DI unsigned xb_ld(unsigned* q)              { return __hip_atomic_load(q, __ATOMIC_RELAXED, __HIP_MEMORY_SCOPE_AGENT); }
DI unsigned xb_add(unsigned* q, unsigned v) { return __hip_atomic_fetch_add(q, v, __ATOMIC_RELAXED, __HIP_MEMORY_SCOPE_AGENT); }
DI unsigned xb_xcc_id() { return (unsigned)__builtin_amdgcn_s_getreg((3 << 11) | 20) & 0xFu; }
#define XB_SPIN(cond, bar) do { unsigned _sp = 0; while (cond) { __builtin_amdgcn_s_sleep(1); \
    if ((++_sp & 255u) == 0u) { if (xb_ld(&(bar)[XB_TMO])) break; if (_sp > XB_SPIN_CAP) { atomicAdd(&(bar)[XB_TMO], 1u); break; } } } } while (0)
struct XcdBarrier { unsigned* bar; unsigned x; volatile lds_u32* st; };
DI XcdBarrier xcd_barrier_post(unsigned* bar, volatile lds_u32* st, int wid) {
    XcdBarrier b; b.bar = bar; b.x = xb_xcc_id(); b.st = st;
    if (wid == 0 && lane_id() == 0) (void)xb_add(&bar[XB_XCNT(b.x)], 1u);
    return b;
}
DI void xcd_barrier_complete(unsigned* bar, unsigned x, unsigned& nloc, unsigned& nx) {
    const unsigned G = gridDim.x;
    unsigned sum, cnt, mine, sp = 0u;
    for (;;) {
        sum = 0u; cnt = 0u; mine = 0u;
#pragma unroll
        for (unsigned j = 0; j < 16; ++j) { const unsigned c = xb_ld(&bar[XB_XCNT(j)]); sum += c; cnt += (c > 0u) ? 1u : 0u; mine = (j == x) ? c : mine; }
        if (sum == G) break;
        __builtin_amdgcn_s_sleep(1);
        if ((++sp & 255u) == 0u) { if (xb_ld(&bar[XB_TMO])) break; if (sp > XB_SPIN_CAP) { atomicAdd(&bar[XB_TMO], 1u); break; } }
    }
    nloc = mine > 0u ? mine : 1u; nx = cnt > 0u ? cnt : 1u;
}
DI void xcd_barrier(const XcdBarrier& b, int wid) {
    asm volatile("s_waitcnt vmcnt(0)" ::: "memory");
    __syncthreads();
    if (wid == 0 && lane_id() == 0) {
        unsigned* bar = b.bar;
        __builtin_amdgcn_s_waitcnt(0);
        unsigned nloc = b.st[0], nx = b.st[1];
        if (nloc == 0u) { xcd_barrier_complete(bar, b.x, nloc, nx); b.st[0] = nloc; b.st[1] = nx; }
        const unsigned old = xb_add(&bar[XB_XSUB(b.x)], 1u);
        const unsigned gen = old / nloc;
        if (old + 1u == (gen + 1u) * nloc) {
            __builtin_amdgcn_fence(__ATOMIC_RELEASE, "agent");
            asm volatile("s_waitcnt vmcnt(0)" ::: "memory");
            const unsigned og = xb_add(&bar[XB_TOP], 1u);
            const unsigned tg = og / nx;
            if (og + 1u == (tg + 1u) * nx) xb_add(&bar[XB_TOPGEN], 1u);
            else XB_SPIN(xb_ld(&bar[XB_TOPGEN]) == tg, bar);
            __builtin_amdgcn_fence(__ATOMIC_ACQUIRE, "agent");
            xb_add(&bar[XB_XGEN(b.x)], 1u);
            asm volatile("s_waitcnt vmcnt(0)" ::: "memory");
        } else {
            XB_SPIN(xb_ld(&bar[XB_XGEN(b.x)]) == gen, bar);
            __builtin_amdgcn_fence(__ATOMIC_ACQUIRE, "agent");
            asm volatile("s_waitcnt vmcnt(0)" ::: "memory");
        }
    }
    __syncthreads();
}

__global__ void __launch_bounds__(512, 2) hybrid_fwd(Params p, int lo, int hi) {
    extern __shared__ __attribute__((aligned(16))) unsigned char dyn_lds[];
    const int wid = __builtin_amdgcn_readfirstlane((int)(threadIdx.x >> 6));
    const int vb = wid >> 2;
    char* smem = (char*)dyn_lds + vb * SMEM_BYTES;
    unsigned* ctl = (unsigned*)(dyn_lds + 2 * SMEM_BYTES);
    if (wid == 0 && lane_id() < 16) ctl[lane_id()] = 0u;
    __syncthreads();
    VBC vc; vc.cnt = (lds_u32*)(ctl + vb); vc.gen = 0u; vc.mail = (int*)(ctl + 2 + vb); vc.wid = wid;
    const XcdBarrier xb = xcd_barrier_post((unsigned*)(p.ws + OFF_BAR), (volatile lds_u32*)(ctl + 4), wid);
#define RUN_PHASE(ph, call) do { if (lo <= (ph) && (ph) < hi) { call; if ((ph) + 1 < hi) { if ((ph) == 0) { asm volatile("s_waitcnt vmcnt(0)" ::: "memory"); cg::this_grid().sync(); } else xcd_barrier(xb, wid); } } } while (0)
    RUN_PHASE(0, phase_pro1(p, smem, vc));
    RUN_PHASE(1, phase_pro2(p, vc));
    LAYER_LOOP_PRAGMA
    for (int layer = 0; layer < DEPTH; ++layer) {
        RUN_PHASE(2 + 5 * layer, phase_gemm_in(p, layer, dyn_lds, wid));
        RUN_PHASE(3 + 5 * layer, phase_mix(p, layer, smem, vc));
        RUN_PHASE(5 + 5 * layer, phase_gemm_out(p, layer, dyn_lds, wid));
        RUN_PHASE(6 + 5 * layer, phase_ln(p, layer, vc));
    }
}

extern "C" void kernel_launch(void* const* d_in, const int* in_sizes, int n_in, void* d_out, int out_size, void* d_ws, size_t ws_size, hipStream_t stream) {
    static int grid = 0;
    if (grid == 0) {
        int dev = 0, cus = 0, per_cu = 0;
        hipGetDevice(&dev);
        hipDeviceGetAttribute(&cus, hipDeviceAttributeMultiprocessorCount, dev);
        (void)hipFuncSetAttribute((const void*)hybrid_fwd, hipFuncAttributeMaxDynamicSharedMemorySize, DYN_LDS);
        (void)hipOccupancyMaxActiveBlocksPerMultiprocessor(&per_cu, (const void*)hybrid_fwd, 512, DYN_LDS);
        per_cu = 1;
        grid = cus * per_cu;
        if (ws_size < WS_END || grid < 96) { fprintf(stderr, "workspace too small: %zu < %zu\n", ws_size, (size_t)WS_END); grid = -1; }
    }
    if (grid < 0) return;
    Params p{};
    p.x = (const float*)d_in[0]; p.c = (const float*)d_in[1]; p.ctx = (const float*)d_in[2]; p.c_ctx = (const float*)d_in[3];
    p.w_mod = (const float*)d_in[4]; p.b_mod = (const float*)d_in[5]; p.w_in = (const float*)d_in[6]; p.sink = (const float*)d_in[7];
    p.dlam = (const float*)d_in[8]; p.dng = (const float*)d_in[9]; p.ib = (const float*)d_in[10]; p.fb = (const float*)d_in[11];
    p.mng = (const float*)d_in[12]; p.w_out = (const float*)d_in[13]; p.ln_g = (const float*)d_in[14]; p.ln_b = (const float*)d_in[15];
    p.out = (float*)d_out; p.ws = (char*)d_ws;
#if ONE_LAUNCH
    hipMemsetAsync((char*)d_ws + OFF_BAR, 0, BAR_BYTES, stream);
    int lo = 0, hi = NPHASE;
    void* args[] = {&p, &lo, &hi};
    hipError_t e = hipLaunchCooperativeKernel((const void*)hybrid_fwd, dim3(grid), dim3(512), args, DYN_LDS, stream);
    if (e != hipSuccess) fprintf(stderr, "cooperative launch failed: %s (grid %d)\n", hipGetErrorString(e), grid);
#else
    for (int ph = 0; ph < NPHASE; ++ph) hipLaunchKernelGGL(hybrid_fwd, dim3(grid), dim3(512), DYN_LDS, stream, p, ph, ph + 1);
#endif
}
```

```cpp
#include <hip/hip_runtime.h>
#include <hip/hip_cooperative_groups.h>
#include <cstdio>
namespace cg = cooperative_groups;

#ifndef LAYER_LOOP_PRAGMA
#define LAYER_LOOP_PRAGMA _Pragma("nounroll")
#endif
#ifndef ONE_LAUNCH
#define ONE_LAUNCH 1
#endif

typedef unsigned short u16;
typedef __attribute__((ext_vector_type(8))) short bf16x8;
typedef __attribute__((ext_vector_type(4))) short s16x4;
typedef __attribute__((ext_vector_type(16))) float f32x16;
typedef __attribute__((ext_vector_type(2))) float f32x2;
typedef __attribute__((ext_vector_type(2))) __bf16 bf2_t;
#define DI __device__ __forceinline__
#define MFMA(a, b, c) __builtin_amdgcn_mfma_f32_32x32x16_bf16((a), (b), (c), 0, 0, 0)

constexpr int DM = 1024, NBATCH = 8, SEQ = 4096, CTXL = 256, DEPTH = 4;
constexpr int NLAT = NBATCH * SEQ;
constexpr int NCTX = NBATCH * CTXL;
constexpr int NTOK = NLAT + NCTX;
constexpr int DIN = 4248, NPAD = 4352;
constexpr int PC = 3392;
constexpr int LDK = 1024;
constexpr int KVS = 4416;
constexpr int KVL = SEQ + CTXL;
constexpr int P_QA = 0, P_KA = 256, P_ZA = 384, P_QB = 640, P_KB = 1024, P_ZB = 1408, P_QM = 1792, P_KM = 2176, P_OM = 2560, P_ZM = 2944;
constexpr float LN_EPS = 1e-5f;
constexpr float ALPHA = 1.6817928305074290f;
constexpr float LOG2E = 1.4426950408889634f;

constexpr size_t SZ_WI = 4ull * NPAD * LDK * 2, SZ_WO = 4ull * 1024 * LDK * 2, SZ_MOD = 4ull * 9 * 3072 * 4;
constexpr size_t OFF_WI = 0;
constexpr size_t OFF_WO = OFF_WI + SZ_WI;
constexpr size_t OFF_MOD = OFF_WO + SZ_WO;
constexpr size_t OFF_TABA = OFF_MOD + SZ_MOD;
constexpr size_t OFF_TABB = OFF_TABA + 8192;
constexpr size_t OFF_LAM = OFF_TABB + 4096;
constexpr size_t OFF_CTR = OFF_LAM + 256;
constexpr size_t OFF_HY = OFF_CTR + 256;
constexpr size_t OFF_P = OFF_HY + (size_t)NTOK * LDK * 2;
constexpr size_t OFF_G = OFF_P + (size_t)NTOK * PC * 2;
constexpr size_t OFF_VAT = OFF_G + (size_t)NTOK * 24 * 4;
constexpr size_t OFF_VBT = OFF_VAT + (size_t)NBATCH * 2 * 64 * KVS * 2;
constexpr size_t OFF_KMT = OFF_VBT + (size_t)NBATCH * 6 * 64 * KVS * 2;
constexpr size_t OFF_VMT = OFF_KMT + (size_t)NBATCH * 6 * 64 * KVS * 2;
constexpr size_t OFF_HD = OFF_VMT + (size_t)NBATCH * 6 * 64 * KVS * 2;
constexpr size_t OFF_XC = OFF_HD + 2ull * NTOK * 384 * 2;
constexpr size_t OFF_BAR = OFF_XC + (size_t)NCTX * 1024 * 4;
constexpr size_t BAR_BYTES = 16384;
constexpr size_t WS_END = OFF_BAR + BAR_BYTES;

struct Params {
    const float *x, *c, *ctx, *c_ctx, *w_mod, *b_mod, *w_in, *sink, *dlam, *dng, *ib, *fb, *mng, *w_out, *ln_g, *ln_b;
    float* out;
    char* ws;
};

constexpr int SMEM_BYTES = 75776;
constexpr int DYN_LDS = 2 * SMEM_BYTES + 64;

DI unsigned pk2(float a, float b) { f32x2 v = {a, b}; bf2_t r = __builtin_convertvector(v, bf2_t); return __builtin_bit_cast(unsigned, r); }
DI u16 f2bf(float a) { return (u16)(pk2(a, 0.f) & 0xffffu); }
DI float bf2f(u16 v) { return __uint_as_float(((unsigned)v) << 16); }
DI float bflo(unsigned v) { return __uint_as_float(v << 16); }
DI float bfhi(unsigned v) { return __uint_as_float(v & 0xffff0000u); }
DI int crow(int e, int h) { return (e & 3) + 8 * (e >> 2) + 4 * h; }
DI float silu_f(float v) { return v / (1.f + __expf(-v)); }
DI float sigmoid_f(float v) { return 1.f / (1.f + __expf(-v)); }
DI bf16x8 pack8(const f32x16& x, int s) {
    uint4 u;
    u.x = pk2(x[8 * s + 0], x[8 * s + 1]); u.y = pk2(x[8 * s + 2], x[8 * s + 3]);
    u.z = pk2(x[8 * s + 4], x[8 * s + 5]); u.w = pk2(x[8 * s + 6], x[8 * s + 7]);
    return __builtin_bit_cast(bf16x8, u);
}
DI bf16x8 ld8(const u16* p) { return __builtin_bit_cast(bf16x8, *(const uint4*)p); }
DI bf16x8 ld4x2(const u16* p0, const u16* p1) { uint2 a = *(const uint2*)p0, b = *(const uint2*)p1; uint4 u = {a.x, a.y, b.x, b.y}; return __builtin_bit_cast(bf16x8, u); }
DI int lane_id() { int l; asm volatile("v_mbcnt_lo_u32_b32 %0, -1, 0\n\tv_mbcnt_hi_u32_b32 %0, -1, %0" : "=v"(l)); return l; }
struct VBC;
DI int opaque_tid(const VBC& vc);
typedef __attribute__((address_space(3))) unsigned lds_u32;
struct VBC { lds_u32* cnt; unsigned gen; int* mail; int wid; };
DI int opaque_tid(const VBC& vc) { int t = ((vc.wid & 3) << 6) | lane_id(); asm volatile("" : "+v"(t)); return t; }
#define VBID ((int)(blockIdx.x * 2 + (vc.wid >> 2)))
#define VGRID ((int)(gridDim.x * 2))
DI void vb_sync(VBC& vc) {
    vc.gen += 4u;
    __builtin_amdgcn_fence(__ATOMIC_RELEASE, "workgroup");
    asm volatile("s_waitcnt lgkmcnt(0)" ::: "memory");
    if (lane_id() == 0) __hip_atomic_fetch_add(vc.cnt, 1u, __ATOMIC_RELAXED, __HIP_MEMORY_SCOPE_WORKGROUP);
    while (__hip_atomic_load(vc.cnt, __ATOMIC_RELAXED, __HIP_MEMORY_SCOPE_WORKGROUP) < vc.gen) __builtin_amdgcn_s_sleep(1);
    __builtin_amdgcn_fence(__ATOMIC_ACQUIRE, "workgroup");
}
#define VSYNC() vb_sync(vc)
DI float wave_sum(float v) { for (int o = 32; o > 0; o >>= 1) v += __shfl_xor(v, o); return v; }
DI float wave_max(float v) { for (int o = 32; o > 0; o >>= 1) v = fmaxf(v, __shfl_xor(v, o)); return v; }

DI int wi_src(int n, float& sc) {
    sc = 1.f;
    if (n >= DIN) return -1;
    if (n < 384) {
        int p = n & 63, base = n & ~63, d;
        if (p < 32) d = (p >> 1) + 16 * (p & 1); else { int q = p - 32; d = 32 + (q >> 1) + 16 * (q & 1); }
        if (n < 256) sc = 0.125f * LOG2E;
        return base + d;
    }
    if (n >= 768 && n < 1536) {
        int p = n & 31, base = n & ~31, d;
        if (p < 16) d = (p >> 1) + 8 * (p & 1); else { int q = p - 16; d = 16 + (q >> 1) + 8 * (q & 1); }
        if (n < 1152) sc = 0.17677669529663687f * LOG2E;
        return base + d;
    }
    if (n >= 2688 && n < 3072) sc = 0.125f;
    return n;
}

DI void sincos_d(double a, float& c, float& s) {
    const double TWO_PI = 6.283185307179586476925;
    double k = rint(a / TWO_PI);
    double r = a - k * TWO_PI;
    double r2 = r * r, ts = r, tc = 1.0, ss = r, cc = 1.0;
    for (int i = 1; i <= 13; ++i) {
        tc *= -r2 / (double)((2 * i - 1) * (2 * i)); cc += tc;
        ts *= -r2 / (double)((2 * i) * (2 * i + 1)); ss += ts;
    }
    c = (float)cc; s = (float)ss;
}

DI void phase_pro1(const Params& p, char* smem, VBC& vc) {
    const int tid = opaque_tid(vc);
    u16* WI = (u16*)(p.ws + OFF_WI);
    u16* WO = (u16*)(p.ws + OFF_WO);
    float* MOD = (float*)(p.ws + OFF_MOD);
    {
        float* tile = (float*)smem;
        const int kk = tid >> 4, c4 = (tid & 15) * 4;
        const int nn = tid >> 2, kc = (tid & 3) * 16;
        constexpr int T_IN = (NPAD / 64) * 16, T_OUT = 16 * 16, T_LAYER = T_IN + T_OUT;
        for (int t = VBID; t < 4 * T_LAYER; t += VGRID) {
            const int l = t / T_LAYER, rem = t - l * T_LAYER;
            const bool is_in = rem < T_IN;
            const int r2 = is_in ? rem : rem - T_IN;
            const int n0 = (r2 >> 4) * 64, k0 = (r2 & 15) * 64;
            const int ncols = is_in ? DIN : 1024;
            const float* w = is_in ? p.w_in + ((size_t)l * 1024 + k0) * DIN + n0 : p.w_out + ((size_t)l * 1024 + k0) * 1024 + n0;
#pragma unroll
            for (int i = 0; i < 4; ++i) {
                const int k = kk + 16 * i;
                float4 v = {0.f, 0.f, 0.f, 0.f};
                if (n0 + c4 + 3 < ncols) v = *(const float4*)(w + (size_t)k * ncols + c4);
                tile[k * 65 + c4] = v.x; tile[k * 65 + c4 + 1] = v.y; tile[k * 65 + c4 + 2] = v.z; tile[k * 65 + c4 + 3] = v.w;
            }
            VSYNC();
            {
                const int n = n0 + nn;
                float sc = 1.f; int src = n;
                if (is_in) src = wi_src(n, sc);
                const int lc = src - n0;
                uint4 o0 = {0u, 0u, 0u, 0u}, o1 = {0u, 0u, 0u, 0u};
                if (src >= 0) {
                    float v[16];
#pragma unroll
                    for (int j = 0; j < 16; ++j) v[j] = tile[(kc + j) * 65 + lc] * sc;
                    o0.x = pk2(v[0], v[1]); o0.y = pk2(v[2], v[3]); o0.z = pk2(v[4], v[5]); o0.w = pk2(v[6], v[7]);
                    o1.x = pk2(v[8], v[9]); o1.y = pk2(v[10], v[11]); o1.z = pk2(v[12], v[13]); o1.w = pk2(v[14], v[15]);
                }
                u16* dst = (is_in ? WI + ((size_t)l * NPAD + n) * LDK : WO + ((size_t)l * 1024 + n) * LDK) + k0 + kc;
                *(uint4*)dst = o0; *(uint4*)(dst + 8) = o1;
            }
            VSYNC();
        }
    }
    float* ssc = (float*)smem;
    float* red = ssc + 9 * 1024;
    bool have = false;
    for (int item = VBID; item < 384; item += VGRID) {
        if (!have) {
            for (int i = tid; i < 9216; i += 256) { int r = i >> 10, k = i & 1023; float v = r < 8 ? p.c[r * 1024 + k] : p.c_ctx[k]; ssc[i] = silu_f(v); }
            VSYNC(); have = true;
        }
        const int l = item / 96, n0 = (item % 96) * 32, nl = tid & 31, ks = tid >> 5;
        const float* w = p.w_mod + ((size_t)l * 1024 + ks * 128) * 3072 + n0 + nl;
        float acc[9];
#pragma unroll
        for (int r = 0; r < 9; ++r) acc[r] = 0.f;
#pragma unroll 8
        for (int k = 0; k < 128; ++k) {
            float wv = w[(size_t)k * 3072];
#pragma unroll
            for (int r = 0; r < 9; ++r) acc[r] += ssc[r * 1024 + ks * 128 + k] * wv;
        }
#pragma unroll
        for (int r = 0; r < 9; ++r) red[(ks * 9 + r) * 32 + nl] = acc[r];
        VSYNC();
        for (int o = tid; o < 288; o += 256) {
            int r = o >> 5, nn = o & 31; float s = p.b_mod[l * 3072 + n0 + nn];
            for (int k2 = 0; k2 < 8; ++k2) s += red[(k2 * 9 + r) * 32 + nn];
            MOD[((size_t)l * 9 + r) * 3072 + n0 + nn] = s;
        }
        VSYNC();
    }
    if (VBID == VGRID - 1) {
        float2* TA = (float2*)(p.ws + OFF_TABA); float2* TB = (float2*)(p.ws + OFF_TABB);
        for (int i = tid; i < 1536; i += 256) {
            int pos, j, nf; if (i < 1024) { pos = i >> 4; j = i & 15; nf = 16; } else { int q = i - 1024; pos = q >> 3; j = q & 7; nf = 8; }
            float inv = (float)exp(-(double)j / (double)nf * 9.210340371976184);
            float ang = (float)pos * inv;
            float c, s; sincos_d((double)ang, c, s);
            if (i < 1024) TA[i] = make_float2(c, s); else TB[i - 1024] = make_float2(c, s);
        }
        if (tid < 4) {
            const float* lv = p.dlam + tid * 128; float s0 = 0.f, s1 = 0.f;
            for (int i = 0; i < 32; ++i) { s0 += lv[i] * lv[32 + i]; s1 += lv[64 + i] * lv[96 + i]; }
            float li = (float)(0.8 - 0.6 * exp(-0.3 * (double)tid));
            float* L = (float*)(p.ws + OFF_LAM); L[tid * 2] = expf(s0) - expf(s1) + li; L[tid * 2 + 1] = li;
        }
        if (tid < 64) ((int*)(p.ws + OFF_CTR))[tid] = 0;
    }
}

DI void phase_pro2(const Params& p, const VBC& vc) {
    u16* H = (u16*)(p.ws + OFF_HY);
    const float* MOD = (const float*)(p.ws + OFF_MOD);
    const int tid = opaque_tid(vc);
    for (long idx = (long)VBID * 256 + tid; idx < (long)NTOK * 128; idx += (long)VGRID * 256) {
        int row = (int)(idx >> 7), kg = (int)(idx & 127);
        const float* src = row < NLAT ? p.x + (size_t)row * 1024 : p.ctx + (size_t)(row - NLAT) * 1024;
        int r = row < NLAT ? (row >> 12) : 8;
        const float* md = MOD + (size_t)r * 3072 + kg * 8;
        float4 a0 = *(const float4*)(src + kg * 8), a1 = *(const float4*)(src + kg * 8 + 4);
        float4 sh0 = *(const float4*)(md), sh1 = *(const float4*)(md + 4), sc0 = *(const float4*)(md + 1024), sc1 = *(const float4*)(md + 1028);
        uint4 o;
        o.x = pk2(a0.x * (1.f + sc0.x) + sh0.x, a0.y * (1.f + sc0.y) + sh0.y);
        o.y = pk2(a0.z * (1.f + sc0.z) + sh0.z, a0.w * (1.f + sc0.w) + sh0.w);
        o.z = pk2(a1.x * (1.f + sc1.x) + sh1.x, a1.y * (1.f + sc1.y) + sh1.y);
        o.w = pk2(a1.z * (1.f + sc1.z) + sh1.z, a1.w * (1.f + sc1.w) + sh1.w);
        *(uint4*)(H + (size_t)row * LDK + kg * 8) = o;
    }
}

namespace pg8 {
#define PG8_LAS __attribute__((address_space(3)))
typedef unsigned short bf16_t;
typedef float f32x4 __attribute__((ext_vector_type(4)));
constexpr int BM = 256, BK = 64, HALF = 128, HTB = HALF * BK * 2  , STAGE_BYTES = 8 * HTB, NXCD = 8, WGM = 8;
DI int lds_byte(int r, int c) { const int st = (r >> 4) * 2 + (c >> 5), rr = r & 15, cc = c & 31, ob = rr * 64 + cc * 2; return st * 1024 + (ob ^ (((ob >> 9) & 1) << 5)); }
DI void stage_rc(int b, int& R, int& C) { const int st = b / 1024, sb = b % 1024, swz = sb ^ (((sb >> 9) & 1) << 5); R = (st >> 1) * 16 + swz / 64; C = (st & 1) * 32 + (swz % 64) / 2; }
DI int perm32(int rho) { const int n = rho >> 4, i = rho & 15; return 8 * (i >> 2) + 4 * n + (i & 3); }
struct Unit { int pm, pn; };
struct Gemm { const bf16_t* A; const bf16_t* Bt; int M, N, K; };
struct StaticOrder {
    int nM, nN, nwg, G, c;
    DI void init(int M, int N, int G_, int c_) { nM = M / BM; nN = N / BM; nwg = nM * nN; G = G_; c = c_; }
    DI bool next(int i, Unit& u) const {
        const long L = (long)i * G + c; if (L >= nwg) return false;
        int wgid = (int)L; { const int q = nwg / NXCD, r = nwg % NXCD, xcd = wgid % NXCD, off = wgid / NXCD; wgid = (xcd < r ? xcd * (q + 1) : r * (q + 1) + (xcd - r) * q) + off; }
        const int nig = WGM * nN, gid = wgid / nig, fm = gid * WGM, gsz = (nM - fm) < WGM ? (nM - fm) : WGM;
        u.pm = fm + ((wgid % nig) % gsz); u.pn = (wgid % nig) / gsz; return true;
    }
};
template <class Epi>
DI void gemm_phase(PG8_LAS unsigned char* lds, const Gemm g, const StaticOrder& S, const Epi& E, const int wid0) {
    int tid = (wid0 << 6) | lane_id(); asm volatile("" : "+v"(tid));
    const int wid = __builtin_amdgcn_readfirstlane(tid >> 6), lane = tid & 63, wr = wid >> 2, wc = wid & 3, fr = lane & 15, fq = lane >> 4;
    const int K = g.K, nt = K / BK;
    unsigned voffA[2], voffB[2];
#pragma unroll
    for (int i = 0; i < 2; ++i) { int R, C; stage_rc(tid * 16 + i * 8192, R, C); const int Rb = Epi::PERM ? ((R & ~31) + perm32(R & 31)) : R;
        voffA[i] = (unsigned)(R * K + C) * 2u; voffB[i] = (unsigned)(Rb * K + C) * 2u; }
    const size_t kstep = (size_t)(BK * 2);
    const size_t hstep = (size_t)HALF * K * 2;
    const size_t tstep = 2 * hstep;
    const unsigned ldsw = (unsigned)wid * 1024u;
    const int aoff = lds_byte(wr * 64 + fr, fq * 8), boff = lds_byte(wc * 32 + fr, fq * 8);
#define PG8_SA(b, h) (((b) * 2 + (h)) * HTB)
#define PG8_SB(b, h) ((4 + (b) * 2 + (h)) * HTB)
#define PG8_STAGE(bufoff, gbase, voff) do { _Pragma("unroll") for (int _i = 0; _i < 2; ++_i) \
        __builtin_amdgcn_global_load_lds((const unsigned*)((const char*)(gbase) + (voff)[_i]), (PG8_LAS unsigned*)(lds + (bufoff) + ldsw + _i * 8192), 16, 0, 0); } while (0)
#define PG8_LDA(dst, b, h) do { _Pragma("unroll") for (int m = 0; m < 4; ++m) _Pragma("unroll") for (int k = 0; k < 2; ++k) dst[m][k] = *(const PG8_LAS bf16x8*)(lds + PG8_SA(b, h) + aoff + m * 2048 + k * 1024); } while (0)
#define PG8_LDB(dst, b, h) do { _Pragma("unroll") for (int n = 0; n < 2; ++n) _Pragma("unroll") for (int k = 0; k < 2; ++k) dst[n][k] = *(const PG8_LAS bf16x8*)(lds + PG8_SB(b, h) + boff + n * 2048 + k * 1024); } while (0)
#define PG8_MMA(ai, bj, At, Bt) do { __builtin_amdgcn_s_setprio(1); _Pragma("unroll") for (int m = 0; m < 4; ++m) _Pragma("unroll") for (int n = 0; n < 2; ++n) _Pragma("unroll") for (int k = 0; k < 2; ++k) \
        acc[ai][bj][m][n] = __builtin_amdgcn_mfma_f32_16x16x32_bf16(Bt[n][k], At[m][k], acc[ai][bj][m][n], 0, 0, 0); __builtin_amdgcn_s_setprio(0); } while (0)
#define PG8_WAIT_V(n) asm volatile("s_waitcnt vmcnt(" #n ")" ::: "memory")
#define PG8_WAIT_L(n) asm volatile("s_waitcnt lgkmcnt(" #n ")" ::: "memory")
#define PG8_BAR __builtin_amdgcn_s_barrier()
#define PG8_SCHED __builtin_amdgcn_sched_barrier(0)
    Unit cur, nxt; int ui = 0;
    if (!S.next(0, cur)) return;
    f32x4 acc[2][2][4][2];
#pragma unroll
    for (int a = 0; a < 2; ++a)
#pragma unroll
        for (int b = 0; b < 2; ++b)
#pragma unroll
            for (int m = 0; m < 4; ++m)
#pragma unroll
                for (int n = 0; n < 2; ++n) acc[a][b][m][n] = (f32x4){0.f, 0.f, 0.f, 0.f};
    bf16x8 At[4][2], B0[2][2], B1[2][2];
    const char* cA = (const char*)g.A + (size_t)cur.pm * tstep; const char* cB = (const char*)g.Bt + (size_t)cur.pn * tstep;
    PG8_STAGE(PG8_SB(0, 0), cB, voffB); PG8_STAGE(PG8_SA(0, 0), cA, voffA); PG8_STAGE(PG8_SB(0, 1), cB + hstep, voffB); PG8_STAGE(PG8_SA(0, 1), cA + hstep, voffA);
    if (wr == 1) PG8_BAR;
    PG8_WAIT_V(4); PG8_BAR;
    PG8_STAGE(PG8_SB(1, 0), cB + kstep, voffB); PG8_STAGE(PG8_SA(1, 0), cA + kstep, voffA); PG8_STAGE(PG8_SB(1, 1), cB + hstep + kstep, voffB);
    PG8_WAIT_V(6); PG8_BAR;
    for (;;) {
        const bool has_next = S.next(ui + 1, nxt);
        const char* nA = has_next ? (const char*)g.A + (size_t)nxt.pm * tstep : cA; const char* nB = has_next ? (const char*)g.Bt + (size_t)nxt.pn * tstep : cB;
        for (int t = 0; t < nt; t += 2) {
            const bool last = (t == nt - 2);
            const char* a1 = cA + (size_t)(t + 1) * kstep;
            const char* a2 = last ? nA : cA + (size_t)(t + 2) * kstep; const char* b2 = last ? nB : cB + (size_t)(t + 2) * kstep;
            const char* a3 = a2 + kstep; const char* b3 = b2 + kstep;
            PG8_LDB(B0, 0, 0); PG8_SCHED; PG8_LDA(At, 0, 0); PG8_STAGE(PG8_SA(1, 1), a1 + hstep, voffA);
            PG8_WAIT_L(8); PG8_BAR; PG8_WAIT_L(0); PG8_MMA(0, 0, At, B0); PG8_BAR; PG8_SCHED;
            PG8_LDB(B1, 0, 1); PG8_STAGE(PG8_SB(0, 0), b2, voffB);
            PG8_BAR; PG8_WAIT_L(0); PG8_MMA(0, 1, At, B1); PG8_BAR;
            PG8_LDA(At, 0, 1); PG8_STAGE(PG8_SA(0, 0), a2, voffA);
            PG8_BAR; PG8_WAIT_L(0); PG8_MMA(1, 0, At, B0); PG8_BAR; PG8_SCHED;
            PG8_STAGE(PG8_SB(0, 1), b2 + hstep, voffB);
            PG8_WAIT_V(6); PG8_BAR; PG8_MMA(1, 1, At, B1); PG8_BAR;
            PG8_LDB(B0, 1, 0); PG8_SCHED; PG8_LDA(At, 1, 0); PG8_STAGE(PG8_SA(0, 1), a2 + hstep, voffA);
            PG8_WAIT_L(8); PG8_BAR; PG8_WAIT_L(0); PG8_MMA(0, 0, At, B0); PG8_BAR; PG8_SCHED;
            PG8_LDB(B1, 1, 1); PG8_STAGE(PG8_SB(1, 0), b3, voffB);
            PG8_BAR; PG8_WAIT_L(0); PG8_MMA(0, 1, At, B1); PG8_BAR;
            PG8_LDA(At, 1, 1); PG8_STAGE(PG8_SA(1, 0), a3, voffA);
            PG8_BAR; PG8_WAIT_L(0); PG8_MMA(1, 0, At, B0); PG8_BAR; PG8_SCHED;
            PG8_STAGE(PG8_SB(1, 1), b3 + hstep, voffB);
            PG8_WAIT_V(6); PG8_BAR; PG8_MMA(1, 1, At, B1); PG8_BAR;
        }
        E(acc, cur, wr, wc, fr, fq);
        if (!has_next) break;
#pragma unroll
        for (int a = 0; a < 2; ++a)
#pragma unroll
            for (int b = 0; b < 2; ++b)
#pragma unroll
                for (int m = 0; m < 4; ++m)
#pragma unroll
                    for (int n = 0; n < 2; ++n) acc[a][b][m][n] = (f32x4){0.f, 0.f, 0.f, 0.f};
        cur = nxt; cA = nA; cB = nB; ++ui;
    }
    PG8_WAIT_V(0);
    if (wr == 0) PG8_BAR;
    PG8_BAR;
#undef PG8_SA
#undef PG8_SB
#undef PG8_STAGE
#undef PG8_LDA
#undef PG8_LDB
#undef PG8_MMA
#undef PG8_WAIT_V
#undef PG8_WAIT_L
#undef PG8_BAR
#undef PG8_SCHED
}
}

DI void st_bf4(u16* dst, float a, float b, float c, float d) { uint2 u = {pk2(a, b), pk2(c, d)}; *(uint2*)dst = u; }
DI void st_bf8(u16* dst, const float (&v)[8]) { uint4 u = {pk2(v[0], v[1]), pk2(v[2], v[3]), pk2(v[4], v[5]), pk2(v[6], v[7])}; *(uint4*)dst = u; }

DI void epi_in8(const Params& p, float (&v)[8], int f0, int tok) {
    if (f0 >= 4248) return;
    u16* P = (u16*)(p.ws + OFF_P);
    const bool is_ctx = tok >= NLAT;
    int b, t, kvpos;
    if (!is_ctx) { b = tok >> 12; t = tok & 4095; kvpos = t; } else { int cc = tok - NLAT; b = cc >> 8; t = cc & 255; kvpos = SEQ + t; }
    kvpos = (kvpos & ~15) | (kvpos & 3) | (((kvpos >> 2) & 1) << 3) | (((kvpos >> 3) & 1) << 2);
    if (f0 < 384 || (f0 >= 768 && f0 < 1536)) {
        if (!is_ctx) {
            const float* cs;
            if (f0 < 384) { const int pp = f0 & 63; const int pos = pp < 32 ? (t >> 6) : (t & 63); cs = (const float*)(p.ws + OFF_TABA) + (pos * 16 + ((pp & 31) >> 1)) * 2; }
            else { const int pp = f0 & 31; const int pos = pp < 16 ? (t >> 6) : (t & 63); cs = (const float*)(p.ws + OFF_TABB) + (pos * 8 + ((pp & 15) >> 1)) * 2; }
            const float4 c0 = *(const float4*)cs, c1 = *(const float4*)(cs + 4);
            float o;
            o = v[0] * c0.x - v[1] * c0.y; v[1] = v[1] * c0.x + v[0] * c0.y; v[0] = o;
            o = v[2] * c0.z - v[3] * c0.w; v[3] = v[3] * c0.z + v[2] * c0.w; v[2] = o;
            o = v[4] * c1.x - v[5] * c1.y; v[5] = v[5] * c1.x + v[4] * c1.y; v[4] = o;
            o = v[6] * c1.z - v[7] * c1.w; v[7] = v[7] * c1.z + v[6] * c1.w; v[6] = o;
        }
        st_bf8(P + (size_t)tok * PC + (f0 < 384 ? f0 : f0 - 128), v);
    } else if (f0 < 512 || (f0 >= 1536 && f0 < 1920) || (f0 >= 3072 && f0 < 3456)) {
        u16* T; int d0;
        if (f0 < 512) { d0 = (f0 - 384) & 63; T = (u16*)(p.ws + OFF_VAT) + ((size_t)(b * 2 + ((f0 - 384) >> 6)) * 64) * KVS; }
        else if (f0 < 1920) { d0 = (f0 - 1536) & 63; T = (u16*)(p.ws + OFF_VBT) + ((size_t)(b * 6 + ((f0 - 1536) >> 6)) * 64) * KVS; }
        else { d0 = (f0 - 3072) & 63; T = (u16*)(p.ws + OFF_VMT) + ((size_t)(b * 6 + ((f0 - 3072) >> 6)) * 64) * KVS; }
#pragma unroll
        for (int e = 0; e < 8; ++e) T[(size_t)(d0 + e) * KVS + kvpos] = f2bf(v[e]);
    } else if (f0 < 768) {
        st_bf8(P + (size_t)tok * PC + (f0 - 128), v);
    } else if (f0 < 3072) {
        st_bf8(P + (size_t)tok * PC + (f0 - 512), v);
        if (f0 >= 2688) {
            const int d0 = (f0 - 2688) & 63;
            u16* T = (u16*)(p.ws + OFF_KMT) + ((size_t)(b * 6 + ((f0 - 2688) >> 6)) * 64) * KVS;
#pragma unroll
            for (int e = 0; e < 8; ++e) T[(size_t)(d0 + e) * KVS + kvpos] = f2bf(v[e]);
        }
    } else if (f0 < 4224) {
        st_bf8(P + (size_t)tok * PC + (f0 - 896), v);
    } else {
        float* G = (float*)(p.ws + OFF_G) + (size_t)tok * 24 + (f0 - 4224);
        *(float4*)G = make_float4(v[0], v[1], v[2], v[3]); *(float4*)(G + 4) = make_float4(v[4], v[5], v[6], v[7]);
    }
}

struct EpiIn {
    static constexpr bool PERM = true;
    const Params* pp;
    DI void operator()(const pg8::f32x4 (&acc)[2][2][4][2], const pg8::Unit& u, int wr, int wc, int fr, int fq) const {
#pragma unroll
        for (int ai = 0; ai < 2; ++ai)
#pragma unroll
            for (int m = 0; m < 4; ++m) {
                const int tok = u.pm * 256 + ai * 128 + wr * 64 + m * 16 + fr;
#pragma unroll
                for (int bj = 0; bj < 2; ++bj) {
                    const int f0 = u.pn * 256 + bj * 128 + wc * 32 + 8 * fq;
                    float v[8];
#pragma unroll
                    for (int e = 0; e < 4; ++e) { v[e] = acc[ai][bj][m][0][e]; v[4 + e] = acc[ai][bj][m][1][e]; }
                    epi_in8(*pp, v, f0, tok);
                }
            }
    }
};

struct EpiOut {
    static constexpr bool PERM = false;
    const Params* pp; int layer;
    DI void operator()(const pg8::f32x4 (&acc)[2][2][4][2], const pg8::Unit& u, int wr, int wc, int fr, int fq) const {
        const Params& p = *pp;
        const float* MOD = (const float*)(p.ws + OFF_MOD);
#pragma unroll
        for (int ai = 0; ai < 2; ++ai)
#pragma unroll
            for (int m = 0; m < 4; ++m) {
                const int tok = u.pm * 256 + ai * 128 + wr * 64 + m * 16 + fr;
                const bool is_ctx = tok >= NLAT;
                const float* src; float* dst; int r;
                if (!is_ctx) { r = tok >> 12; src = (layer == 0 ? p.x : p.out) + (size_t)tok * 1024; dst = p.out + (size_t)tok * 1024; }
                else { r = 8; float* xc = (float*)(p.ws + OFF_XC) + (size_t)(tok - NLAT) * 1024; src = layer == 0 ? p.ctx + (size_t)(tok - NLAT) * 1024 : xc; dst = xc; }
                const float* gate = MOD + ((size_t)layer * 9 + r) * 3072 + 2048;
#pragma unroll
                for (int bj = 0; bj < 2; ++bj)
#pragma unroll
                    for (int n = 0; n < 2; ++n) {
                        const int col = u.pn * 256 + bj * 128 + wc * 32 + 16 * n + 4 * fq;
                        const float4 xv = *(const float4*)(src + col), gv = *(const float4*)(gate + col);
                        float4 o;
                        o.x = ALPHA * xv.x + gv.x * acc[ai][bj][m][n][0]; o.y = ALPHA * xv.y + gv.y * acc[ai][bj][m][n][1];
                        o.z = ALPHA * xv.z + gv.z * acc[ai][bj][m][n][2]; o.w = ALPHA * xv.w + gv.w * acc[ai][bj][m][n][3];
                        *(float4*)(dst + col) = o;
                    }
            }
    }
};

DI void phase_gemm_in(const Params& p, int layer, unsigned char* dyn_lds, int wid) {
    pg8::Gemm g{(const u16*)(p.ws + OFF_HY), (const u16*)(p.ws + OFF_WI) + (size_t)layer * NPAD * LDK, NTOK, NPAD, 1024};
    pg8::StaticOrder S; S.init(NTOK, NPAD, (int)gridDim.x, (int)blockIdx.x);
    EpiIn E{&p};
    pg8::gemm_phase<EpiIn>((PG8_LAS unsigned char*)dyn_lds, g, S, E, wid);
}
DI void phase_gemm_out(const Params& p, int layer, unsigned char* dyn_lds, int wid) {
    const int M = layer == DEPTH - 1 ? NLAT : NTOK;
    pg8::Gemm g{(const u16*)(p.ws + OFF_HY), (const u16*)(p.ws + OFF_WO) + (size_t)layer * 1024 * LDK, M, 1024, 1024};
    pg8::StaticOrder S; S.init(M, 1024, (int)gridDim.x, (int)blockIdx.x);
    EpiOut E{&p, layer};
    pg8::gemm_phase<EpiOut>((PG8_LAS unsigned char*)dyn_lds, g, S, E, wid);
}

constexpr int AST = 72;

template <int NS>
DI void attn_item(const Params& p, int layer, char* smem, VBC& vc, int b, int hq, int qblk) {
    constexpr int DQK = 64 / NS, NKS = DQK / 16;
    const u16* P = (const u16*)(p.ws + OFF_P);
    u16* Y = (u16*)(p.ws + OFF_HY);
    const int tid = opaque_tid(vc), lane = tid & 63, wave = tid >> 6, r = lane & 31, h = lane >> 5;
    u16* sK = (u16*)smem;
    const bool qctx = qblk >= 32;
    const int qrow0 = qctx ? NLAT + b * CTXL + (qblk - 32) * 128 : b * SEQ + qblk * 128;
    const int qcol = NS == 1 ? P_QA + hq * 64 : P_QB + hq * 64;
    const int kcol = NS == 1 ? P_KA + (hq >> 1) * 64 : P_KB + hq * 64;
    const u16* VT = NS == 1 ? (const u16*)(p.ws + OFF_VAT) + ((size_t)(b * 2 + (hq >> 1)) * 64) * KVS
                            : (const u16*)(p.ws + OFF_VBT) + ((size_t)(b * 6 + hq) * 64) * KVS;
    int lat0, lat1;
    if (qctx) { lat0 = 0; lat1 = 0; }
    else if (NS == 1) { lat0 = max(0, (qblk - 1) * 2); lat1 = min(64, (qblk + 2) * 2); }
    else { lat0 = 0; lat1 = 64; }
    const int ntiles = (lat1 - lat0) + 4;
    const int qpos = qblk * 128 + wave * 32 + r;
    bf16x8 qf[NS][NKS];
    {
        const u16* qp = P + (size_t)(qrow0 + wave * 32 + r) * PC + qcol + h * 8;
#pragma unroll
        for (int m = 0; m < NS; ++m)
#pragma unroll
            for (int ks = 0; ks < NKS; ++ks) qf[m][ks] = ld8(qp + m * DQK + ks * 16);
    }
    const float cexp = 1.f;
    float mrun[NS], lrun[NS];
    f32x16 O[NS][2];
    unsigned qaug[NS];
    auto init_state = [&]() {
#pragma unroll
        for (int m = 0; m < NS; ++m) {
            if (NS == 1) { mrun[m] = p.sink[layer * 4 + hq] * LOG2E; lrun[m] = h == 0 ? 1.f : 0.f; }
            else { mrun[m] = -1e30f; lrun[m] = 0.f; }
            qaug[m] = 0u;
#pragma unroll
            for (int t = 0; t < 2; ++t)
#pragma unroll
                for (int e = 0; e < 16; ++e) O[m][t][e] = 0.f;
        }
    };
    init_state();
    const int wave4 = tid >> 6;
    const int drow = lane >> 3, dslot = lane & 7;
    auto tile_ptrs = [&](int it, const u16*& kp, const u16*& vp) {
        if (it < lat1 - lat0) { int kt = lat0 + it; kp = P + (size_t)(b * SEQ + kt * 64) * PC + kcol; vp = VT + kt * 64; }
        else { int c = it - (lat1 - lat0); kp = P + (size_t)(NLAT + b * CTXL + c * 64) * PC + kcol; vp = VT + SEQ + c * 64; }
    };
    auto dma_tile = [&](int it, int st) {
        const u16 *kp, *vp; tile_ptrs(it, kp, vp);
#pragma unroll
        for (int i = 0; i < 2; ++i) {
            const int row = wave4 * 16 + i * 8 + drow;
            const int chunk = dslot ^ ((row >> 1) & 7);
            lds_u32* dk = (lds_u32*)(sK + st * 8192 + (wave4 * 16 + i * 8) * 64);
            lds_u32* dv = (lds_u32*)(sK + st * 8192 + 4096 + (wave4 * 16 + i * 8) * 64);
            __builtin_amdgcn_global_load_lds((const unsigned*)(kp + (size_t)row * PC + chunk * 8), dk, 16, 0, 0);
            __builtin_amdgcn_global_load_lds((const unsigned*)(vp + (size_t)row * KVS + chunk * 8), dv, 16, 0, 0);
        }
    };
    const int hs16 = ((h ^ ((r >> 1) & 7)) << 3);
    const bf16x8 kones = __builtin_bit_cast(bf16x8, (uint4){0x00003F80u, 0u, 0u, 0u});
    auto run_tiles = [&](const bool fast) {
    dma_tile(0, 0);
    asm volatile("s_waitcnt vmcnt(0)" ::: "memory");
    VSYNC();
    for (int it = 0; it < ntiles; ++it) {
        const int buf = it & 1;
        if (it + 1 < ntiles) dma_tile(it + 1, buf ^ 1);
        const u16* cK = sK + buf * 8192; const u16* cV = cK + 4096;
        const bool is_lat = it < lat1 - lat0;
        const int kpos0 = (lat0 + it) * 64;
        auto qk = [&](const int m, f32x16 (&s)[2]) {
#pragma unroll
            for (int kt2 = 0; kt2 < 2; ++kt2)
#pragma unroll
                for (int e = 0; e < 16; ++e) s[kt2][e] = 0.f;
            __builtin_amdgcn_s_setprio(1);
#pragma unroll
            for (int ks = 0; ks < NKS; ++ks)
#pragma unroll
                for (int kt2 = 0; kt2 < 2; ++kt2) s[kt2] = MFMA(ld8(cK + (kt2 * 32 + r) * 64 + (((m * DQK + ks * 16)) ^ hs16)), qf[m][ks], s[kt2]);
#pragma unroll
            for (int kt2 = 0; kt2 < 2; ++kt2) { uint4 qa4 = {qaug[m], 0u, 0u, 0u}; s[kt2] = MFMA(kones, __builtin_bit_cast(bf16x8, qa4), s[kt2]); }
            __builtin_amdgcn_s_setprio(0);
        };
        auto softmax = [&](const int m, f32x16 (&s)[2], bf16x8 (&pf)[2][2]) {
            const bool fixed = fast && it > 0;
            if (NS == 1 && is_lat) {
#pragma unroll
                for (int kt2 = 0; kt2 < 2; ++kt2)
#pragma unroll
                    for (int e = 0; e < 16; ++e) {
                        int d = kpos0 + kt2 * 32 + crow(e, h) - qpos;
                        if (d > 128 || d < -128) s[kt2][e] = -1e30f;
                    }
            }
            if (fixed) {
                float ls = 0.f;
#pragma unroll
                for (int kt2 = 0; kt2 < 2; ++kt2)
#pragma unroll
                    for (int e = 0; e < 16; ++e) { const float pv = __builtin_amdgcn_exp2f(s[kt2][e]); s[kt2][e] = pv; ls += pv; }
                lrun[m] += ls;
            } else {
                float tmax = -1e30f;
    #pragma unroll
                for (int kt2 = 0; kt2 < 2; ++kt2)
    #pragma unroll
                    for (int e = 0; e < 16; ++e) tmax = fmaxf(tmax, s[kt2][e]);
                tmax = fmaxf(tmax, __shfl_xor(tmax, 32));
                float mnew = fmaxf(mrun[m], tmax * cexp);
                if (fast) mnew = bf2f(f2bf(mnew));
                const float alpha = __builtin_amdgcn_exp2f(mrun[m] - mnew);
                mrun[m] = mnew;
                f32x2 ls2 = {0.f, 0.f};
                const f32x2 cc2 = {cexp, cexp}, mm2 = {-mnew, -mnew};
    #pragma unroll
                for (int kt2 = 0; kt2 < 2; ++kt2)
    #pragma unroll
                    for (int e = 0; e < 16; e += 2) {
                        f32x2 sv = {s[kt2][e], s[kt2][e + 1]};
                        sv = __builtin_elementwise_fma(sv, cc2, mm2);
                        f32x2 pv = {__builtin_amdgcn_exp2f(sv.x), __builtin_amdgcn_exp2f(sv.y)};
                        s[kt2][e] = pv.x; s[kt2][e + 1] = pv.y; ls2 += pv;
                    }
                lrun[m] = lrun[m] * alpha + (ls2.x + ls2.y);
                if (__any(alpha != 1.f)) {
    #pragma unroll
                    for (int t = 0; t < 2; ++t)
    #pragma unroll
                        for (int e = 0; e < 16; ++e) O[m][t][e] *= alpha;
                }
                if (fast) {
                    qaug[m] = h == 0 ? (unsigned)f2bf(-mrun[m]) : 0u;
                }
            }
#pragma unroll
            for (int kt2 = 0; kt2 < 2; ++kt2) { pf[kt2][0] = pack8(s[kt2], 0); pf[kt2][1] = pack8(s[kt2], 1); }
        };
        auto pvm = [&](const int m, const bf16x8 (&pf)[2][2]) {
            __builtin_amdgcn_s_setprio(1);
#pragma unroll
            for (int kk = 0; kk < 4; ++kk)
#pragma unroll
                for (int dvt = 0; dvt < 2; ++dvt) O[m][dvt] = MFMA(ld8(cV + (dvt * 32 + r) * 64 + ((kk * 16) ^ hs16)), pf[kk >> 1][kk & 1], O[m][dvt]);
            __builtin_amdgcn_s_setprio(0);
        };
        {
            f32x16 sa[2]; bf16x8 pfa[2][2];
            qk(0, sa);
            __builtin_amdgcn_sched_barrier(0);
            softmax(0, sa, pfa);
            __builtin_amdgcn_sched_barrier(0);
            if (NS == 2) {
                f32x16 sb[2]; bf16x8 pfb[2][2];
                qk(NS - 1, sb);
                pvm(0, pfa);
                softmax(NS - 1, sb, pfb);
                __builtin_amdgcn_sched_barrier(0);
                pvm(NS - 1, pfb);
            } else {
                pvm(0, pfa);
            }
            __builtin_amdgcn_sched_barrier(0);
        }
        asm volatile("s_waitcnt vmcnt(0)" ::: "memory");
        VSYNC();
    }
    };
    for (int attempt = 0; attempt < 2; ++attempt) {
        if (attempt) init_state();
        run_tiles(attempt == 0);
        bool bad = !(lrun[0] < 1e37f);
        if (NS == 2) bad = bad || !(lrun[NS - 1] < 1e37f);
        int* flag = vc.mail;
        if (tid == 0) *flag = 0;
        VSYNC();
        if (bad) *flag = 1;
        VSYNC();
        const int redo = *flag;
        VSYNC();
        if (!redo) break;
    }
    const int tok = qrow0 + wave * 32 + r;
    if (NS == 1) {
        float l = lrun[0] + __shfl_xor(lrun[0], 32);
        const float inv = 1.f / l;
        const u16* zp = P + (size_t)tok * PC + P_ZA + hq * 64;
        u16* yp = Y + (size_t)tok * LDK + hq * 64;
#pragma unroll
        for (int t = 0; t < 2; ++t)
#pragma unroll
            for (int g = 0; g < 4; ++g) {
                const int dv = t * 32 + 8 * g + 4 * h;
                uint2 z = *(const uint2*)(zp + dv);
                st_bf4(yp + dv, O[0][t][4 * g] * inv * silu_f(bflo(z.x)), O[0][t][4 * g + 1] * inv * silu_f(bfhi(z.x)),
                       O[0][t][4 * g + 2] * inv * silu_f(bflo(z.y)), O[0][t][4 * g + 3] * inv * silu_f(bfhi(z.y)));
            }
    } else {
        const float* L = (const float*)(p.ws + OFF_LAM);
        const float lam = L[layer * 2], lam_init = L[layer * 2 + 1];
        float l0 = lrun[0] + __shfl_xor(lrun[0], 32), l1 = lrun[NS - 1] + __shfl_xor(lrun[NS - 1], 32);
        const float i0 = 1.f / l0, i1 = lam / l1;
        float ss = 0.f;
#pragma unroll
        for (int t = 0; t < 2; ++t)
#pragma unroll
            for (int e = 0; e < 16; ++e) { float o = O[0][t][e] * i0 - O[NS - 1][t][e] * i1; O[0][t][e] = o; ss += o * o; }
        ss += __shfl_xor(ss, 32);
        const float rs = rsqrtf(ss * (1.f / 64.f) + LN_EPS) * (1.f - lam_init);
        const u16* zp = P + (size_t)tok * PC + P_ZB + hq * 64;
        u16* yp = Y + (size_t)tok * LDK + 256 + hq * 64;
        const float* gn = p.dng + layer * 64;
#pragma unroll
        for (int t = 0; t < 2; ++t)
#pragma unroll
            for (int g = 0; g < 4; ++g) {
                const int dv = t * 32 + 8 * g + 4 * h;
                uint2 z = *(const uint2*)(zp + dv);
                float4 gv = *(const float4*)(gn + dv);
                st_bf4(yp + dv, O[0][t][4 * g] * rs * gv.x * silu_f(bflo(z.x)), O[0][t][4 * g + 1] * rs * gv.y * silu_f(bfhi(z.x)),
                       O[0][t][4 * g + 2] * rs * gv.z * silu_f(bflo(z.y)), O[0][t][4 * g + 3] * rs * gv.w * silu_f(bfhi(z.y)));
            }
    }
}

DI float logsig(float x) { return fminf(x, 0.f) - log1pf(__expf(-fabsf(x))); }

DI void mlstm_chain(const Params& p, int layer, char* smem, VBC& vc, int chain) {
    const int b = chain / 12, rem = chain % 12, hd = rem >> 1, dir = rem & 1;
    const u16* P = (const u16*)(p.ws + OFF_P);
    const float* G = (const float*)(p.ws + OFF_G);
    const u16* KT = (const u16*)(p.ws + OFF_KMT) + ((size_t)(b * 6 + hd) * 64) * KVS;
    const u16* VT = (const u16*)(p.ws + OFF_VMT) + ((size_t)(b * 6 + hd) * 64) * KVS;
    u16* HD = (u16*)(p.ws + OFF_HD) + (size_t)dir * NTOK * 384;
    const int tid = opaque_tid(vc), lane = tid & 63, wave = tid >> 6, r = lane & 31, h = lane >> 5, tt = wave & 1, vh = wave >> 1;
    u16* sQ = (u16*)smem; u16* sK = sQ + 64 * AST; u16* sKT = sK + 64 * AST; u16* sVT = sKT + 64 * AST;
    float* fl = (float*)(sVT + 64 * AST);
    float *s_ig = fl, *s_fg = fl + 64, *s_b = fl + 128, *s_a = fl + 192, *s_mt = fl + 256, *s_wi = fl + 320, *s_w = fl + 384, *s_nq = fl + 448, *s_n = fl + 512, *s_sc = fl + 576;
    const float ibias = p.ib[layer * 12 + dir * 6 + hd], fbias = p.fb[layer * 12 + dir * 6 + hd];
    f32x16 Cst[2];
#pragma unroll
    for (int t = 0; t < 2; ++t)
#pragma unroll
        for (int e = 0; e < 16; ++e) Cst[t][e] = 0.f;
    float m_state = 0.f, n_reg = 0.f;
    if (tid < 64) s_n[tid] = 0.f;
    const int lrow = tid >> 3, lpart = tid & 7;
    uint4 rq0, rq1, rk0, rk1, rkt0, rkt1, rvt0, rvt1; float rgi = 0.f, rgf = 0.f;
    auto chunk_pos = [&](int step, int& prow0, int& kv0) {
        if (step < 4) { int j = dir ? 3 - step : step; prow0 = NLAT + b * CTXL + j * 64; kv0 = SEQ + j * 64; }
        else { int c = dir ? 63 - (step - 4) : step - 4; prow0 = b * SEQ + c * 64; kv0 = c * 64; }
    };
    auto issue = [&](int step) {
        int prow0, kv0; chunk_pos(step, prow0, kv0);
        const u16* qp = P + (size_t)(prow0 + lrow) * PC + P_QM + hd * 64 + lpart * 8;
        rq0 = *(const uint4*)qp; rq1 = *(const uint4*)(qp + (size_t)32 * PC);
        const u16* kp = P + (size_t)(prow0 + lrow) * PC + P_KM + hd * 64 + lpart * 8;
        rk0 = *(const uint4*)kp; rk1 = *(const uint4*)(kp + (size_t)32 * PC);
        const u16* ktp = KT + (size_t)lrow * KVS + kv0 + lpart * 8;
        rkt0 = *(const uint4*)ktp; rkt1 = *(const uint4*)(ktp + (size_t)32 * KVS);
        const u16* vtp = VT + (size_t)lrow * KVS + kv0 + lpart * 8;
        rvt0 = *(const uint4*)vtp; rvt1 = *(const uint4*)(vtp + (size_t)32 * KVS);
        if (tid < 64) { const float* g = G + (size_t)(prow0 + tid) * 24 + dir * 12 + hd; rgi = g[0]; rgf = g[6]; }
    };
    issue(0);
    for (int step = 0; step < 68; ++step) {
        int prow0, kv0; chunk_pos(step, prow0, kv0);
        *(uint4*)(sQ + lrow * AST + lpart * 8) = rq0; *(uint4*)(sQ + (lrow + 32) * AST + lpart * 8) = rq1;
        *(uint4*)(sK + lrow * AST + lpart * 8) = rk0; *(uint4*)(sK + (lrow + 32) * AST + lpart * 8) = rk1;
        *(uint4*)(sKT + lrow * AST + lpart * 8) = rkt0; *(uint4*)(sKT + (lrow + 32) * AST + lpart * 8) = rkt1;
        *(uint4*)(sVT + lrow * AST + lpart * 8) = rvt0; *(uint4*)(sVT + (lrow + 32) * AST + lpart * 8) = rvt1;
        if (tid < 64) { s_ig[tid] = rgi + ibias; s_fg[tid] = logsig(rgf + fbias); }
        VSYNC();
        if (step + 1 < 68) issue(step + 1);
        if (wave == 0) {
            const float ig = s_ig[lane], lf = s_fg[lane];
            float bb = lf;
#pragma unroll
            for (int off = 1; off < 64; off <<= 1) {
                float v = dir ? __shfl_down(bb, off) : __shfl_up(bb, off);
                bool ok = dir ? (lane + off < 64) : (lane >= off);
                if (ok) bb += v;
            }
            const float aa = ig - bb;
            float cm = aa;
#pragma unroll
            for (int off = 1; off < 64; off <<= 1) {
                float v = dir ? __shfl_down(cm, off) : __shfl_up(cm, off);
                bool ok = dir ? (lane + off < 64) : (lane >= off);
                if (ok) cm = fmaxf(cm, v);
            }
            const float mt = fmaxf(bb + m_state, bb + cm);
            const float wi = __expf(bb + m_state - mt);
            const float b_last = __shfl(bb, dir ? 0 : 63);
            const float amax = wave_max(aa);
            const float m_new = fmaxf(b_last + m_state, b_last + amax);
            const float w = __expf(b_last + aa - m_new);
            const float decay = __expf(b_last + m_state - m_new);
            s_w[lane] = w;
            float nq = 0.f;
#pragma unroll
            for (int d8 = 0; d8 < 8; ++d8) {
                uint4 qv = *(const uint4*)(sQ + lane * AST + d8 * 8);
                float4 n0 = *(const float4*)(s_n + d8 * 8), n1 = *(const float4*)(s_n + d8 * 8 + 4);
                nq += bflo(qv.x) * n0.x + bfhi(qv.x) * n0.y + bflo(qv.y) * n0.z + bfhi(qv.y) * n0.w
                    + bflo(qv.z) * n1.x + bfhi(qv.z) * n1.y + bflo(qv.w) * n1.z + bfhi(qv.w) * n1.w;
            }
            float nacc = 0.f;
#pragma unroll
            for (int s8 = 0; s8 < 8; ++s8) {
                uint4 kv = *(const uint4*)(sKT + lane * AST + s8 * 8);
                float4 w0 = *(const float4*)(s_w + (s8 >> 1) * 16 + 4 * (s8 & 1)), w1 = *(const float4*)(s_w + (s8 >> 1) * 16 + 8 + 4 * (s8 & 1));
                nacc += bflo(kv.x) * w0.x + bfhi(kv.x) * w0.y + bflo(kv.y) * w0.z + bfhi(kv.y) * w0.w
                      + bflo(kv.z) * w1.x + bfhi(kv.z) * w1.y + bflo(kv.w) * w1.z + bfhi(kv.w) * w1.w;
            }
            n_reg = decay * n_reg + nacc;
            s_b[lane] = bb; s_a[lane] = aa; s_mt[lane] = mt; s_wi[lane] = wi; s_nq[lane] = nq; s_n[lane] = n_reg;
            if (lane == 0) s_sc[0] = decay;
            m_state = m_new;
        }
        VSYNC();
        {
            const int t = tt * 32 + r;
            const float bt = s_b[t], mtt = s_mt[t], wit = s_wi[t];
            bf16x8 qfr[4];
#pragma unroll
            for (int ks = 0; ks < 4; ++ks) qfr[ks] = ld8(sQ + t * AST + ks * 16 + h * 8);
            bf16x8 pf[2][2];
            float dsum = 0.f;
            {
                f32x16 sx[2];
#pragma unroll
                for (int si = 0; si < 2; ++si)
#pragma unroll
                    for (int e = 0; e < 16; ++e) sx[si][e] = 0.f;
#pragma unroll
                for (int ks = 0; ks < 4; ++ks)
#pragma unroll
                    for (int si = 0; si < 2; ++si) sx[si] = MFMA(ld8(sK + (si * 32 + r) * AST + ks * 16 + h * 8), qfr[ks], sx[si]);
#pragma unroll
                for (int si = 0; si < 2; ++si) {
#pragma unroll
                    for (int e = 0; e < 16; ++e) {
                        const int sidx = si * 32 + crow(e, h);
                        const bool valid = dir ? (sidx >= t) : (sidx <= t);
                        const float dm = valid ? __expf(bt + s_a[sidx] - mtt) : 0.f;
                        const float pv = sx[si][e] * dm; sx[si][e] = pv; dsum += pv;
                    }
                    pf[si][0] = pack8(sx[si], 0); pf[si][1] = pack8(sx[si], 1);
                }
            }
            dsum += __shfl_xor(dsum, 32);
            f32x16 Z;
#pragma unroll
            for (int e = 0; e < 16; ++e) Z[e] = 0.f;
#pragma unroll
            for (int dt = 0; dt < 2; ++dt)
#pragma unroll
                for (int sp = 0; sp < 2; ++sp) {
                    const u16* qp = sQ + t * AST + dt * 32 + sp * 16 + 4 * h;
                    Z = MFMA(pack8(Cst[dt], sp), ld4x2(qp, qp + 8), Z);
                }
#pragma unroll
            for (int e = 0; e < 16; ++e) Z[e] *= wit;
#pragma unroll
            for (int kk = 0; kk < 4; ++kk) {
                const int si = kk >> 1, sp = kk & 1;
                Z = MFMA(ld8(sVT + (vh * 32 + r) * AST + si * 32 + sp * 16 + 8 * h), pf[si][sp], Z);
            }
            const float den = wit * s_nq[t] + dsum;
            const float inv = 1.f / fmaxf(fabsf(den), __expf(-mtt));
            u16* hp = HD + (size_t)(prow0 + t) * 384 + hd * 64 + vh * 32 + 4 * h;
#pragma unroll
            for (int g = 0; g < 4; ++g) st_bf4(hp + 8 * g, Z[4 * g] * inv, Z[4 * g + 1] * inv, Z[4 * g + 2] * inv, Z[4 * g + 3] * inv);
            const float decay = s_sc[0];
            bf16x8 wv[4];
#pragma unroll
            for (int ks = 0; ks < 4; ++ks) {
                uint4 vv = *(const uint4*)(sVT + (vh * 32 + r) * AST + ks * 16 + h * 8);
                float4 w0 = *(const float4*)(s_w + ks * 16 + 4 * h), w1 = *(const float4*)(s_w + ks * 16 + 8 + 4 * h);
                uint4 u;
                u.x = pk2(bflo(vv.x) * w0.x, bfhi(vv.x) * w0.y); u.y = pk2(bflo(vv.y) * w0.z, bfhi(vv.y) * w0.w);
                u.z = pk2(bflo(vv.z) * w1.x, bfhi(vv.z) * w1.y); u.w = pk2(bflo(vv.w) * w1.z, bfhi(vv.w) * w1.w);
                wv[ks] = __builtin_bit_cast(bf16x8, u);
            }
#pragma unroll
            for (int dt = 0; dt < 2; ++dt)
#pragma unroll
                for (int e = 0; e < 16; ++e) Cst[dt][e] *= decay;
#pragma unroll
            for (int ks = 0; ks < 4; ++ks)
#pragma unroll
                for (int dt = 0; dt < 2; ++dt) Cst[dt] = MFMA(ld8(sKT + (dt * 32 + r) * AST + ks * 16 + h * 8), wv[ks], Cst[dt]);
        }
        VSYNC();
    }
}

DI int next_item(int* ctr, int* s_item, VBC& vc) {
    if ((vc.wid & 3) == 0 && lane_id() == 0) *s_item = atomicAdd(ctr, 1);
    VSYNC();
    int item = *s_item;
    VSYNC();
    return item;
}
DI void phase_mix(const Params& p, int layer, char* smem, VBC& vc) {
    int* const s_item_p = vc.mail;
    const int xcd = blockIdx.x & 7;
    int* ctr = (int*)(p.ws + OFF_CTR) + layer * 16 + xcd;
    const bool with_ctx = layer < DEPTH - 1;
    if ((vc.wid >> 2) == 0 && blockIdx.x < 96) { __builtin_amdgcn_s_setprio(3); mlstm_chain(p, layer, smem, vc, blockIdx.x); __builtin_amdgcn_s_setprio(0); }
    const int nB = 6 * 32, nBc = with_ctx ? 6 * 2 : 0;
    while (true) {
        int item = next_item(ctr, s_item_p, vc);
        if (item >= nB + nBc) break;
        int k, qb;
        if (item < nB) { k = item >> 5; qb = item & 31; } else { item -= nB; k = item >> 1; qb = 32 + (item & 1); }
        const int pb = xcd + 8 * k;
        attn_item<2>(p, layer, smem, vc, pb / 6, pb % 6, qb);
    }
    const int nA = 2 * 64, nAc = with_ctx ? 2 * 4 : 0;
    while (true) {
        int item = next_item(ctr + 8, s_item_p, vc);
        if (item >= nA + nAc) break;
        int k, hl, qb;
        if (item < nA) { k = item >> 6; hl = (item >> 5) & 1; qb = item & 31; } else { item -= nA; k = item >> 2; hl = (item >> 1) & 1; qb = 32 + (item & 1); }
        const int pk = xcd + 8 * k;
        attn_item<1>(p, layer, smem, vc, pk >> 1, 2 * (pk & 1) + hl, qb);
    }
}

DI void phase_fin(const Params& p, int layer, const VBC& vc) {
    const int ntok = layer < DEPTH - 1 ? NTOK : NLAT;
    const u16* P = (const u16*)(p.ws + OFF_P);
    const u16* HF = (const u16*)(p.ws + OFF_HD); const u16* HB = HF + (size_t)NTOK * 384;
    u16* Y = (u16*)(p.ws + OFF_HY);
    const float* gn = p.mng + layer * 384;
    const int tid = opaque_tid(vc);
    for (long idx = (long)VBID * 256 + tid; idx < (long)ntok * 96; idx += (long)VGRID * 256) {
        const int tok = (int)(idx / 96), rem = (int)(idx % 96), hd = rem >> 4, q = rem & 15, col = hd * 64 + q * 4;
        uint2 a = *(const uint2*)(HF + (size_t)tok * 384 + col), bq = *(const uint2*)(HB + (size_t)tok * 384 + col);
        float s0 = bflo(a.x) + bflo(bq.x), s1 = bfhi(a.x) + bfhi(bq.x), s2 = bflo(a.y) + bflo(bq.y), s3 = bfhi(a.y) + bfhi(bq.y);
        float ss = s0 * s0 + s1 * s1 + s2 * s2 + s3 * s3;
        ss += __shfl_xor(ss, 1); ss += __shfl_xor(ss, 2); ss += __shfl_xor(ss, 4); ss += __shfl_xor(ss, 8);
        const float rs = rsqrtf(ss * (1.f / 64.f) + LN_EPS);
        float4 gv = *(const float4*)(gn + col);
        uint2 o = *(const uint2*)(P + (size_t)tok * PC + P_OM + col), z = *(const uint2*)(P + (size_t)tok * PC + P_ZM + col);
        st_bf4(Y + (size_t)tok * LDK + 640 + col,
               s0 * rs * gv.x * sigmoid_f(bflo(o.x)) * silu_f(bflo(z.x)), s1 * rs * gv.y * sigmoid_f(bfhi(o.x)) * silu_f(bfhi(z.x)),
               s2 * rs * gv.z * sigmoid_f(bflo(o.y)) * silu_f(bflo(z.y)), s3 * rs * gv.w * sigmoid_f(bfhi(o.y)) * silu_f(bfhi(z.y)));
    }
}

DI void phase_ln(const Params& p, int layer, const VBC& vc) {
    const int nrows = layer < DEPTH - 1 ? NTOK : NLAT;
    const float* MOD = (const float*)(p.ws + OFF_MOD);
    u16* H = (u16*)(p.ws + OFF_HY);
    const float* g = p.ln_g + layer * 1024; const float* bta = p.ln_b + layer * 1024;
    const int tid = opaque_tid(vc);
    const int lane = tid & 63, gw = VBID * 4 + (tid >> 6), nw = VGRID * 4;
    for (int row = gw; row < nrows; row += nw) {
        float* xr = row < NLAT ? p.out + (size_t)row * 1024 : (float*)(p.ws + OFF_XC) + (size_t)(row - NLAT) * 1024;
        float4 v[4];
        float s = 0.f;
#pragma unroll
        for (int j = 0; j < 4; ++j) { v[j] = *(const float4*)(xr + lane * 4 + 256 * j); s += v[j].x + v[j].y + v[j].z + v[j].w; }
        const float mean = wave_sum(s) * (1.f / 1024.f);
        float q = 0.f;
#pragma unroll
        for (int j = 0; j < 4; ++j) { v[j].x -= mean; v[j].y -= mean; v[j].z -= mean; v[j].w -= mean; q += v[j].x * v[j].x + v[j].y * v[j].y + v[j].z * v[j].z + v[j].w * v[j].w; }
        const float rstd = rsqrtf(wave_sum(q) * (1.f / 1024.f) + LN_EPS);
        const int r = row < NLAT ? (row >> 12) : 8;
        const float* md = MOD + ((size_t)(layer + 1) * 9 + r) * 3072;
#pragma unroll
        for (int j = 0; j < 4; ++j) {
            const int n = lane * 4 + 256 * j;
            float4 gv = *(const float4*)(g + n), bv = *(const float4*)(bta + n), o;
            o.x = v[j].x * rstd * gv.x + bv.x; o.y = v[j].y * rstd * gv.y + bv.y; o.z = v[j].z * rstd * gv.z + bv.z; o.w = v[j].w * rstd * gv.w + bv.w;
            *(float4*)(xr + n) = o;
            if (layer < DEPTH - 1) {
                float4 sh = *(const float4*)(md + n), sc = *(const float4*)(md + 1024 + n);
                st_bf4(H + (size_t)row * LDK + n, o.x * (1.f + sc.x) + sh.x, o.y * (1.f + sc.y) + sh.y, o.z * (1.f + sc.z) + sh.z, o.w * (1.f + sc.w) + sh.w);
            }
        }
    }
}

constexpr int NPHASE = 2 + 5 * DEPTH;
#define XB_TMO      128
#define XB_XCNT(j)  (256  + 64 * (j))
#define XB_XSUB(j)  (1280 + 64 * (j))
#define XB_XGEN(j)  (2304 + 64 * (j))
#define XB_TOP      3328
#define XB_TOPGEN   3392
#define XB_SPIN_CAP (1u << 18)
DI unsigned xb_ld(unsigned* q)              { return __hip_atomic_load(q, __ATOMIC_RELAXED, __HIP_MEMORY_SCOPE_AGENT); }
DI unsigned xb_add(unsigned* q, unsigned v) { return __hip_atomic_fetch_add(q, v, __ATOMIC_RELAXED, __HIP_MEMORY_SCOPE_AGENT); }
DI unsigned xb_xcc_id() { return (unsigned)__builtin_amdgcn_s_getreg((3 << 11) | 20) & 0xFu; }
#define XB_SPIN(cond, bar) do { unsigned _sp = 0; while (cond) { __builtin_amdgcn_s_sleep(1); \
    if ((++_sp & 255u) == 0u) { if (xb_ld(&(bar)[XB_TMO])) break; if (_sp > XB_SPIN_CAP) { atomicAdd(&(bar)[XB_TMO], 1u); break; } } } } while (0)
struct XcdBarrier { unsigned* bar; unsigned x; volatile lds_u32* st; };
DI XcdBarrier xcd_barrier_post(unsigned* bar, volatile lds_u32* st, int wid) {
    XcdBarrier b; b.bar = bar; b.x = xb_xcc_id(); b.st = st;
    if (wid == 0 && lane_id() == 0) (void)xb_add(&bar[XB_XCNT(b.x)], 1u);
    return b;
}
DI void xcd_barrier_complete(unsigned* bar, unsigned x, unsigned& nloc, unsigned& nx) {
    const unsigned G = gridDim.x;
    unsigned sum, cnt, mine, sp = 0u;
    for (;;) {
        sum = 0u; cnt = 0u; mine = 0u;
#pragma unroll
        for (unsigned j = 0; j < 16; ++j) { const unsigned c = xb_ld(&bar[XB_XCNT(j)]); sum += c; cnt += (c > 0u) ? 1u : 0u; mine = (j == x) ? c : mine; }
        if (sum == G) break;
        __builtin_amdgcn_s_sleep(1);
        if ((++sp & 255u) == 0u) { if (xb_ld(&bar[XB_TMO])) break; if (sp > XB_SPIN_CAP) { atomicAdd(&bar[XB_TMO], 1u); break; } }
    }
    nloc = mine > 0u ? mine : 1u; nx = cnt > 0u ? cnt : 1u;
}
DI void xcd_barrier(const XcdBarrier& b, int wid) {
    asm volatile("s_waitcnt vmcnt(0)" ::: "memory");
    __syncthreads();
    if (wid == 0 && lane_id() == 0) {
        unsigned* bar = b.bar;
        __builtin_amdgcn_s_waitcnt(0);
        unsigned nloc = b.st[0], nx = b.st[1];
        if (nloc == 0u) { xcd_barrier_complete(bar, b.x, nloc, nx); b.st[0] = nloc; b.st[1] = nx; }
        const unsigned old = xb_add(&bar[XB_XSUB(b.x)], 1u);
        const unsigned gen = old / nloc;
        if (old + 1u == (gen + 1u) * nloc) {
            __builtin_amdgcn_fence(__ATOMIC_RELEASE, "agent");
            asm volatile("s_waitcnt vmcnt(0)" ::: "memory");
            const unsigned og = xb_add(&bar[XB_TOP], 1u);
            const unsigned tg = og / nx;
            if (og + 1u == (tg + 1u) * nx) xb_add(&bar[XB_TOPGEN], 1u);
            else XB_SPIN(xb_ld(&bar[XB_TOPGEN]) == tg, bar);
            __builtin_amdgcn_fence(__ATOMIC_ACQUIRE, "agent");
            xb_add(&bar[XB_XGEN(b.x)], 1u);
            asm volatile("s_waitcnt vmcnt(0)" ::: "memory");
        } else {
            XB_SPIN(xb_ld(&bar[XB_XGEN(b.x)]) == gen, bar);
            __builtin_amdgcn_fence(__ATOMIC_ACQUIRE, "agent");
            asm volatile("s_waitcnt vmcnt(0)" ::: "memory");
        }
    }
    __syncthreads();
}

__global__ void __launch_bounds__(512, 2) hybrid_fwd(Params p, int lo, int hi) {
    extern __shared__ __attribute__((aligned(16))) unsigned char dyn_lds[];
    const int wid = __builtin_amdgcn_readfirstlane((int)(threadIdx.x >> 6));
    const int vb = wid >> 2;
    char* smem = (char*)dyn_lds + vb * SMEM_BYTES;
    unsigned* ctl = (unsigned*)(dyn_lds + 2 * SMEM_BYTES);
    if (wid == 0 && lane_id() < 16) ctl[lane_id()] = 0u;
    __syncthreads();
    VBC vc; vc.cnt = (lds_u32*)(ctl + vb); vc.gen = 0u; vc.mail = (int*)(ctl + 2 + vb); vc.wid = wid;
    const XcdBarrier xb = xcd_barrier_post((unsigned*)(p.ws + OFF_BAR), (volatile lds_u32*)(ctl + 4), wid);
#define RUN_PHASE(ph, call) do { if (lo <= (ph) && (ph) < hi) { call; if ((ph) + 1 < hi) { if ((ph) == 0) { asm volatile("s_waitcnt vmcnt(0)" ::: "memory"); cg::this_grid().sync(); } else xcd_barrier(xb, wid); } } } while (0)
    RUN_PHASE(0, phase_pro1(p, smem, vc));
    RUN_PHASE(1, phase_pro2(p, vc));
    LAYER_LOOP_PRAGMA
    for (int layer = 0; layer < DEPTH; ++layer) {
        RUN_PHASE(2 + 5 * layer, phase_gemm_in(p, layer, dyn_lds, wid));
        RUN_PHASE(3 + 5 * layer, phase_mix(p, layer, smem, vc));
        RUN_PHASE(4 + 5 * layer, phase_fin(p, layer, vc));
        RUN_PHASE(5 + 5 * layer, phase_gemm_out(p, layer, dyn_lds, wid));
        RUN_PHASE(6 + 5 * layer, phase_ln(p, layer, vc));
    }
}

extern "C" void kernel_launch(void* const* d_in, const int* in_sizes, int n_in, void* d_out, int out_size, void* d_ws, size_t ws_size, hipStream_t stream) {
    static int grid = 0;
    if (grid == 0) {
        int dev = 0, cus = 0, per_cu = 0;
        hipGetDevice(&dev);
        hipDeviceGetAttribute(&cus, hipDeviceAttributeMultiprocessorCount, dev);
        (void)hipFuncSetAttribute((const void*)hybrid_fwd, hipFuncAttributeMaxDynamicSharedMemorySize, DYN_LDS);
        (void)hipOccupancyMaxActiveBlocksPerMultiprocessor(&per_cu, (const void*)hybrid_fwd, 512, DYN_LDS);
        per_cu = 1;
        grid = cus * per_cu;
        if (ws_size < WS_END || grid < 96) { fprintf(stderr, "workspace too small: %zu < %zu\n", ws_size, (size_t)WS_END); grid = -1; }
    }
    if (grid < 0) return;
    Params p{};
    p.x = (const float*)d_in[0]; p.c = (const float*)d_in[1]; p.ctx = (const float*)d_in[2]; p.c_ctx = (const float*)d_in[3];
    p.w_mod = (const float*)d_in[4]; p.b_mod = (const float*)d_in[5]; p.w_in = (const float*)d_in[6]; p.sink = (const float*)d_in[7];
    p.dlam = (const float*)d_in[8]; p.dng = (const float*)d_in[9]; p.ib = (const float*)d_in[10]; p.fb = (const float*)d_in[11];
    p.mng = (const float*)d_in[12]; p.w_out = (const float*)d_in[13]; p.ln_g = (const float*)d_in[14]; p.ln_b = (const float*)d_in[15];
    p.out = (float*)d_out; p.ws = (char*)d_ws;
#if ONE_LAUNCH
    hipMemsetAsync((char*)d_ws + OFF_BAR, 0, BAR_BYTES, stream);
    int lo = 0, hi = NPHASE;
    void* args[] = {&p, &lo, &hi};
    hipError_t e = hipLaunchCooperativeKernel((const void*)hybrid_fwd, dim3(grid), dim3(512), args, DYN_LDS, stream);
    if (e != hipSuccess) fprintf(stderr, "cooperative launch failed: %s (grid %d)\n", hipGetErrorString(e), grid);
#else
    for (int ph = 0; ph < NPHASE; ++ph) hipLaunchKernelGGL(hybrid_fwd, dim3(grid), dim3(512), DYN_LDS, stream, p, ph, ph + 1);
#endif
}
```
